# Optimizing an MI355X kernel written in HIP

```python
import math
import jax, jax.numpy as jnp
from jax import lax
import numpy as np

D_MODEL = 1024
BATCH = 8
SEQ = 2048
DEPTH = 1

GRID_W = 64
CTX_LEN = 256
LRU_WIDTH = 1024
LRU_HEADS = 8
LRU_HEAD_DIM = LRU_WIDTH // LRU_HEADS
LRU_C = 8.0
CONV_WIDTH = 4
CONV_PAD_LEFT = 2
CONV_PAD_RIGHT = CONV_WIDTH - 1 - CONV_PAD_LEFT
FOURIER_WIDTH = 512
FOURIER_GROUPS = 4
FOURIER_GROUP_DIM = FOURIER_WIDTH // FOURIER_GROUPS
N_BRANCHES = 2
IN_COLS = 2 * LRU_WIDTH + FOURIER_WIDTH + N_BRANCHES * D_MODEL
D_FF = 4 * D_MODEL
N_MOD = 6
EPS = 1e-6
POS_MAX_PERIOD = 10000.0

kernel_name = "hybrid_rglru_fnet_dit_block"


def rms_norm(x, g):
    xf = x.astype(jnp.float32)
    y = xf * lax.rsqrt(jnp.mean(xf * xf, axis=-1, keepdims=True) + EPS)
    return (y * g.astype(jnp.float32)).astype(x.dtype)


def modulate(h, shift, scale):
    return h * (1 + scale) + shift


def sincos_1d(pos, dim):
    half = dim // 2
    freqs = jnp.exp(-math.log(POS_MAX_PERIOD) * jnp.arange(half, dtype=jnp.float32) / half)
    ang = pos[:, None] * freqs[None, :]
    return jnp.concatenate([jnp.sin(ang), jnp.cos(ang)], axis=-1)


def grid_pos_embed(n_tokens, dtype):
    rows = n_tokens // GRID_W
    er = sincos_1d(jnp.arange(rows, dtype=jnp.float32), D_MODEL // 2)
    ec = sincos_1d(jnp.arange(GRID_W, dtype=jnp.float32), D_MODEL // 2)
    emb = jnp.concatenate([
        jnp.broadcast_to(er[:, None, :], (rows, GRID_W, D_MODEL // 2)),
        jnp.broadcast_to(ec[None, :, :], (rows, GRID_W, D_MODEL // 2)),
    ], axis=-1)
    return emb.reshape(rows * GRID_W, D_MODEL).astype(dtype)


def depthwise_conv(u, w, b):
    t = u.shape[1]
    up = jnp.pad(u, ((0, 0), (CONV_PAD_LEFT, CONV_PAD_RIGHT), (0, 0)))
    y = b
    for k in range(CONV_WIDTH):
        y = y + up[:, k:k + t] * w[k]
    return y


def rglru_coeffs(xc, w_a, b_a, w_x, b_x, lam):
    bsz, t, _ = xc.shape
    xh = xc.reshape(bsz, t, LRU_HEADS, LRU_HEAD_DIM)
    r = jax.nn.sigmoid(jnp.einsum('bthd,nhde->nbthe', xh, w_a).reshape(2, bsz, t, LRU_WIDTH)
                       + b_a[:, None, None, :])
    i = jax.nn.sigmoid(jnp.einsum('bthd,nhde->nbthe', xh, w_x).reshape(2, bsz, t, LRU_WIDTH)
                       + b_x[:, None, None, :])
    log_a = -LRU_C * r.astype(jnp.float32) * jax.nn.softplus(-lam.astype(jnp.float32))[:, None, None, :]
    a = jnp.exp(log_a)
    mult = jnp.sqrt(-jnp.expm1(2.0 * log_a))
    bterm = mult * (i * xc[None]).astype(jnp.float32)
    return a, bterm


def linear_scan(a, b, h0, reverse):
    def combine(l, r):
        a_l, b_l = l
        a_r, b_r = r
        return a_l * a_r, a_r * b_l + b_r
    a_cum, h = lax.associative_scan(combine, (a, b), reverse=reverse, axis=1)
    return h + a_cum * h0[:, None, :]


def bidir_rglru(xc_ctx, xc_lat, w_a, b_a, w_x, b_x, lam):
    a_c, b_c = rglru_coeffs(xc_ctx, w_a, b_a, w_x, b_x, lam)
    zeros = jnp.zeros((xc_ctx.shape[0], LRU_WIDTH), jnp.float32)
    h_cf = linear_scan(a_c[0], b_c[0], zeros, reverse=False)
    h_cb = linear_scan(a_c[1], b_c[1], zeros, reverse=True)
    a_l, b_l = rglru_coeffs(xc_lat, w_a, b_a, w_x, b_x, lam)
    h_lf = linear_scan(a_l[0], b_l[0], h_cf[:, -1], reverse=False)
    h_lb = linear_scan(a_l[1], b_l[1], h_cb[:, 0], reverse=True)
    return h_cf, h_cb, (h_lf + h_lb).astype(xc_lat.dtype)


def fourier_mix(u):
    bsz, t, _ = u.shape
    ug = u.astype(jnp.float32).reshape(bsz, t, FOURIER_GROUPS, FOURIER_GROUP_DIM)
    y = jnp.fft.fft2(ug, axes=(1, 3), norm="ortho").real
    return y.reshape(bsz, t, FOURIER_WIDTH).astype(u.dtype)


def split_in_cols(u):
    ux = u[..., :LRU_WIDTH]
    uy = u[..., LRU_WIDTH:2 * LRU_WIDTH]
    uf = u[..., 2 * LRU_WIDTH:2 * LRU_WIDTH + FOURIER_WIDTH]
    ug = u[..., 2 * LRU_WIDTH + FOURIER_WIDTH:]
    return ux, uy, uf, ug


def branch_merge(y_lru, uy, uf, ug, w_lru_out, w_f_out, w_out):
    y_a = (y_lru * jax.nn.gelu(uy)) @ w_lru_out
    y_b = fourier_mix(uf) @ w_f_out
    g = jax.nn.sigmoid(ug)
    merged = g[..., :D_MODEL] * y_a + g[..., D_MODEL:] * y_b
    return merged @ w_out


def sq_relu_mlp(h, w1, w2):
    return jnp.square(jax.nn.relu(h @ w1)) @ w2


def setup_inputs(seed: int = 0) -> dict:
    key = jax.random.key(seed)
    ks = jax.random.split(key, 24)
    f32 = jnp.float32
    nrm = lambda k, shape, fan_in: jax.random.normal(k, shape, f32) * (fan_in ** -0.5)
    u = jax.random.uniform(ks[12], (DEPTH, 2, LRU_WIDTH), f32, minval=0.9, maxval=0.999)
    s = u ** (1.0 / LRU_C)
    lam = jnp.log(s) - jnp.log1p(-s)
    return {
        "x": jax.random.normal(ks[0], (BATCH, SEQ, D_MODEL), f32),
        "c": jax.random.normal(ks[1], (BATCH, D_MODEL), f32),
        "ctx": jax.random.normal(ks[2], (BATCH, CTX_LEN, D_MODEL), f32),
        "c_ctx": jax.random.normal(ks[3], (D_MODEL,), f32),
        "w_mod": nrm(ks[4], (DEPTH, D_MODEL, N_MOD * D_MODEL), D_MODEL),
        "b_mod": 0.01 * jax.random.normal(ks[5], (DEPTH, N_MOD * D_MODEL), f32),
        "g_mix": 1.0 + 0.05 * jax.random.normal(ks[6], (DEPTH, D_MODEL), f32),
        "w_in": nrm(ks[7], (DEPTH, D_MODEL, IN_COLS), D_MODEL),
        "conv_w": nrm(ks[8], (DEPTH, CONV_WIDTH, LRU_WIDTH), CONV_WIDTH),
        "conv_b": 0.01 * jax.random.normal(ks[9], (DEPTH, LRU_WIDTH), f32),
        "w_a": nrm(ks[10], (DEPTH, 2, LRU_HEADS, LRU_HEAD_DIM, LRU_HEAD_DIM), LRU_HEAD_DIM),
        "b_a": 0.01 * jax.random.normal(ks[11], (DEPTH, 2, LRU_WIDTH), f32),
        "w_x": nrm(ks[13], (DEPTH, 2, LRU_HEADS, LRU_HEAD_DIM, LRU_HEAD_DIM), LRU_HEAD_DIM),
        "b_x": 0.01 * jax.random.normal(ks[14], (DEPTH, 2, LRU_WIDTH), f32),
        "lam": lam,
        "w_lru_out": nrm(ks[15], (DEPTH, LRU_WIDTH, D_MODEL), LRU_WIDTH),
        "w_f_out": nrm(ks[16], (DEPTH, FOURIER_WIDTH, D_MODEL), FOURIER_WIDTH),
        "w_out": nrm(ks[17], (DEPTH, D_MODEL, D_MODEL), D_MODEL),
        "g_mlp": 1.0 + 0.05 * jax.random.normal(ks[18], (DEPTH, D_MODEL), f32),
        "w1": nrm(ks[19], (DEPTH, D_MODEL, D_FF), D_MODEL),
        "w2": nrm(ks[20], (DEPTH, D_FF, D_MODEL), D_FF),
        "g_final": 1.0 + 0.05 * jax.random.normal(ks[21], (D_MODEL,), f32),
    }


def reference(x, c, ctx, c_ctx, w_mod, b_mod, g_mix, w_in, conv_w, conv_b, w_a, b_a, w_x, b_x,
              lam, w_lru_out, w_f_out, w_out, g_mlp, w1, w2, g_final):
    n_lat = x.shape[1]
    x = x + grid_pos_embed(n_lat, x.dtype)[None]
    for i in range(DEPTH):
        last = i == DEPTH - 1
        mod_l = [m[:, None, :] for m in jnp.split(jax.nn.silu(c) @ w_mod[i] + b_mod[i], N_MOD, axis=-1)]
        mod_c = jnp.split(jax.nn.silu(c_ctx) @ w_mod[i] + b_mod[i], N_MOD, axis=-1)
        sh1, sc1, gt1, sh2, sc2, gt2 = mod_l
        sh1c, sc1c, gt1c, sh2c, sc2c, gt2c = mod_c

        h_lat = modulate(rms_norm(x, g_mix[i]), sh1, sc1)
        h_ctx = modulate(rms_norm(ctx, g_mix[i]), sh1c, sc1c)
        ux_l, uy_l, uf_l, ug_l = split_in_cols(h_lat @ w_in[i])
        if last:
            ux_c = h_ctx @ w_in[i][:, :LRU_WIDTH]
        else:
            ux_c, uy_c, uf_c, ug_c = split_in_cols(h_ctx @ w_in[i])
        xc_l = depthwise_conv(ux_l, conv_w[i], conv_b[i])
        xc_c = depthwise_conv(ux_c, conv_w[i], conv_b[i])
        h_cf, h_cb, y_lru_l = bidir_rglru(xc_c, xc_l, w_a[i], b_a[i], w_x[i], b_x[i], lam[i])
        x = x + gt1 * branch_merge(y_lru_l, uy_l, uf_l, ug_l, w_lru_out[i], w_f_out[i], w_out[i])

        x = x + gt2 * sq_relu_mlp(modulate(rms_norm(x, g_mlp[i]), sh2, sc2), w1[i], w2[i])

        if not last:
            y_lru_c = (h_cf + h_cb).astype(ctx.dtype)
            ctx = ctx + gt1c * branch_merge(y_lru_c, uy_c, uf_c, ug_c, w_lru_out[i], w_f_out[i], w_out[i])
            ctx = ctx + gt2c * sq_relu_mlp(modulate(rms_norm(ctx, g_mlp[i]), sh2c, sc2c), w1[i], w2[i])
    return rms_norm(x, g_final)
```

```cpp
#include <hip/hip_runtime.h>
#include <cstdio>
#include <cstdint>
#define MK_N_LAUNCHES 1
namespace pg8 {
#define PG8_LAS __attribute__((address_space(3)))
typedef unsigned short bf16_t;
typedef short bf16x8 __attribute__((ext_vector_type(8)));
typedef float f32x4 __attribute__((ext_vector_type(4)));
typedef unsigned u32x4 __attribute__((ext_vector_type(4)));
constexpr int BM = 256, BK = 64, HALF = 128, HTB = HALF * BK * 2  , STAGE_BYTES = 8 * HTB, NXCD = 8, WGM = 8;

__host__ __device__ __forceinline__ int lds_byte(int r, int c) { const int st = (r >> 4) * 2 + (c >> 5), rr = r & 15, cc = c & 31, ob = rr * 64 + cc * 2; return st * 1024 + (ob ^ (((ob >> 9) & 1) << 5)); }
__host__ __device__ __forceinline__ void stage_rc(int b, int& R, int& C) { const int st = b / 1024, sb = b % 1024, swz = sb ^ (((sb >> 9) & 1) << 5); R = (st >> 1) * 16 + swz / 64; C = (st & 1) * 32 + (swz % 64) / 2; }
__host__ __device__ __forceinline__ int perm32(int rho) { const int n = rho >> 4, i = rho & 15; return 8 * (i >> 2) + 4 * n + (i & 3); }

struct Unit { int pm, pn; };
struct Gemm { const bf16_t* A; const bf16_t* Bt; int M, N, K; };

struct StaticOrder {
    int nM, nN, nwg, G, c;
    __host__ __device__ void init(int M, int N, int G_, int c_) { nM = M / BM; nN = N / BM; nwg = nM * nN; G = G_; c = c_; }
    __host__ __device__ bool next(int i, Unit& u) const {
        const long L = (long)i * G + c; if (L >= nwg) return false;
        int wgid = (int)L; { const int q = nwg / NXCD, r = nwg % NXCD, xcd = wgid % NXCD, off = wgid / NXCD; wgid = (xcd < r ? xcd * (q + 1) : r * (q + 1) + (xcd - r) * q) + off; }
        const int nig = WGM * nN, gid = wgid / nig, fm = gid * WGM, gsz = (nM - fm) < WGM ? (nM - fm) : WGM;
        u.pm = fm + ((wgid % nig) % gsz); u.pn = (wgid % nig) / gsz; return true;
    }
    __device__ __forceinline__ void a_ready(const Unit&) const {}
    __device__ __forceinline__ void done(const Unit&) const {}
};

__device__ __forceinline__ unsigned cvt_pk_bf16(float lo, float hi) { unsigned r; asm volatile("v_cvt_pk_bf16_f32 %0, %1, %2" : "=v"(r) : "v"(lo), "v"(hi)); return r; }
__device__ __forceinline__ float bf_lo(unsigned w) { return __uint_as_float(w << 16); }
__device__ __forceinline__ float bf_hi(unsigned w) { return __uint_as_float(w & 0xffff0000u); }
__device__ __forceinline__ float sigm(float x) { return __builtin_amdgcn_rcpf(1.0f + __expf(-x)); }
__device__ __forceinline__ float gelu_tanh(float x) { const float z = 1.5957691216f * (x + 0.044715f * x * x * x); return x * sigm(z); }
__device__ __forceinline__ u32x4 pack8(const f32x4 v0, const f32x4 v1) { u32x4 w; w.x = cvt_pk_bf16(v0[0], v0[1]); w.y = cvt_pk_bf16(v0[2], v0[3]); w.z = cvt_pk_bf16(v1[0], v1[1]); w.w = cvt_pk_bf16(v1[2], v1[3]); return w; }

struct EpiInMain {
    static constexpr bool PERM = true, AFTER_DRAIN = false;
    bf16_t* UX; bf16_t* UY; bf16_t* UG;
    __device__ __forceinline__ void operator()(const f32x4 (&acc)[2][2][4][2], const Unit& u, int wr, int wc, int fr, int fq) const {
        const int row0 = u.pm * BM + wr * 64 + fr; const int ct = u.pn * BM;
        bf16_t* base; int ldc, colt, act;
        if (ct < 1024) { base = UX; ldc = 1024; colt = ct; act = 0; }
        else if (ct < 2048) { base = UY; ldc = 1024; colt = ct - 1024; act = 1; }
        else { base = UG; ldc = 2048; colt = ct - 2048; act = 2; }
        const int col0 = colt + wc * 32 + 8 * fq;
#pragma unroll
        for (int ai = 0; ai < 2; ++ai)
#pragma unroll
            for (int m = 0; m < 4; ++m) { bf16_t* rowp = base + (size_t)(row0 + ai * HALF + m * 16) * ldc + col0;
#pragma unroll
                for (int bj = 0; bj < 2; ++bj) { f32x4 v0 = acc[ai][bj][m][0], v1 = acc[ai][bj][m][1];
                    if (act == 1) {
#pragma unroll
                        for (int j = 0; j < 4; ++j) { v0[j] = gelu_tanh(v0[j]); v1[j] = gelu_tanh(v1[j]); } }
                    if (act == 2) {
#pragma unroll
                        for (int j = 0; j < 4; ++j) { v0[j] = sigm(v0[j]); v1[j] = sigm(v1[j]); } }
                    *(u32x4*)(rowp + bj * HALF) = pack8(v0, v1); } }
    }
};
template <int ACT  > struct EpiBf16 {
    static constexpr bool PERM = true, AFTER_DRAIN = false;
    bf16_t* O; int ldc;
    __device__ __forceinline__ void operator()(const f32x4 (&acc)[2][2][4][2], const Unit& u, int wr, int wc, int fr, int fq) const {
        const int row0 = u.pm * BM + wr * 64 + fr; const int col0 = u.pn * BM + wc * 32 + 8 * fq;
#pragma unroll
        for (int ai = 0; ai < 2; ++ai)
#pragma unroll
            for (int m = 0; m < 4; ++m) { bf16_t* rowp = O + (size_t)(row0 + ai * HALF + m * 16) * ldc + col0;
#pragma unroll
                for (int bj = 0; bj < 2; ++bj) { f32x4 v0 = acc[ai][bj][m][0], v1 = acc[ai][bj][m][1];
                    if (ACT == 1) {
#pragma unroll
                        for (int j = 0; j < 4; ++j) { const float a = fmaxf(v0[j], 0.f), b = fmaxf(v1[j], 0.f); v0[j] = a * a; v1[j] = b * b; } }
                    *(u32x4*)(rowp + bj * HALF) = pack8(v0, v1); } }
    }
};
struct EpiPQT {
    static constexpr bool PERM = true, AFTER_DRAIN = false;
    bf16_t* PQT;
    __device__ __forceinline__ void operator()(const f32x4 (&acc)[2][2][4][2], const Unit& u, int wr, int wc, int fr, int fq) const {
        const int row0 = u.pm * BM + wr * 64 + fr; const int col0 = u.pn * BM + wc * 32 + 8 * fq;
#pragma unroll
        for (int ai = 0; ai < 2; ++ai)
#pragma unroll
            for (int m = 0; m < 4; ++m) { const int row = row0 + ai * HALF + m * 16; const int pq = row >> 9, j = row & 511;
#pragma unroll
                for (int bj = 0; bj < 2; ++bj) { const int col = col0 + bj * HALF; const int b = col >> 11, t = col & 2047;
                    bf16_t* p = PQT + (((size_t)(b * 512 + j) * 2 + pq) * 2048 + t);
                    *(u32x4*)p = pack8(acc[ai][bj][m][0], acc[ai][bj][m][1]); } }
    }
};
struct EpiDft {
    static constexpr bool PERM = true, AFTER_DRAIN = false;
    bf16_t* YF;
    __device__ __forceinline__ void operator()(const f32x4 (&acc)[2][2][4][2], const Unit& u, int wr, int wc, int fr, int fq) const {
        const int row0 = u.pm * BM + wr * 64 + fr; const int col0 = u.pn * BM + wc * 32 + 8 * fq;
#pragma unroll
        for (int ai = 0; ai < 2; ++ai)
#pragma unroll
            for (int m = 0; m < 4; ++m) { const int k = row0 + ai * HALF + m * 16;
#pragma unroll
                for (int bj = 0; bj < 2; ++bj) { const int col = col0 + bj * HALF; const int b = col >> 9, j = col & 511;
                    bf16_t* p = YF + ((size_t)(b * 2048 + k) * 512 + j);
                    *(u32x4*)p = pack8(acc[ai][bj][m][0], acc[ai][bj][m][1]); } }
    }
};
template <bool HAS_ADD> struct EpiGate {
    static constexpr bool PERM = true, AFTER_DRAIN = false;
    bf16_t* O; int ldc; const bf16_t* G; int ldg; const bf16_t* ADD;
    __device__ __forceinline__ void operator()(const f32x4 (&acc)[2][2][4][2], const Unit& u, int wr, int wc, int fr, int fq) const {
        const int row0 = u.pm * BM + wr * 64 + fr; const int col0 = u.pn * BM + wc * 32 + 8 * fq;
#pragma unroll
        for (int ai = 0; ai < 2; ++ai)
#pragma unroll
            for (int m = 0; m < 4; ++m) { const size_t row = (size_t)(row0 + ai * HALF + m * 16);
#pragma unroll
                for (int bj = 0; bj < 2; ++bj) { const int col = col0 + bj * HALF;
                    const u32x4 g = *(const u32x4*)(G + row * ldg + col);
                    f32x4 v0 = acc[ai][bj][m][0], v1 = acc[ai][bj][m][1];
                    v0[0] *= bf_lo(g.x); v0[1] *= bf_hi(g.x); v0[2] *= bf_lo(g.y); v0[3] *= bf_hi(g.y);
                    v1[0] *= bf_lo(g.z); v1[1] *= bf_hi(g.z); v1[2] *= bf_lo(g.w); v1[3] *= bf_hi(g.w);
                    if (HAS_ADD) { const u32x4 a = *(const u32x4*)(ADD + row * ldc + col);
                        v0[0] += bf_lo(a.x); v0[1] += bf_hi(a.x); v0[2] += bf_lo(a.y); v0[3] += bf_hi(a.y);
                        v1[0] += bf_lo(a.z); v1[1] += bf_hi(a.z); v1[2] += bf_lo(a.w); v1[3] += bf_hi(a.w); }
                    *(u32x4*)(O + row * ldc + col) = pack8(v0, v1); } }
    }
};
template <int MODE> struct EpiResid {
    static constexpr bool PERM = false, AFTER_DRAIN = false;
    const float* X; float* O; const float* gate  ; const float* pos  ;
    __device__ __forceinline__ void operator()(const f32x4 (&acc)[2][2][4][2], const Unit& u, int wr, int wc, int fr, int fq) const {
        const int row0 = u.pm * BM + wr * 64 + fr, col0 = u.pn * BM + wc * 32 + 4 * fq;
#pragma unroll
        for (int ai = 0; ai < 2; ++ai)
#pragma unroll
            for (int m = 0; m < 4; ++m) { const int row = row0 + ai * HALF + m * 16; const int b = row >> 11, t = row & 2047;
#pragma unroll
                for (int bj = 0; bj < 2; ++bj)
#pragma unroll
                    for (int n = 0; n < 2; ++n) { const int c = col0 + bj * HALF + n * 16;
                        const f32x4 gt = *(const f32x4*)(gate + (size_t)b * 6144 + c);
                        f32x4 base;
                        if (MODE == 0) { const f32x4 pv = (c < 512) ? *(const f32x4*)(pos + (t >> 6) * 512 + c) : *(const f32x4*)(pos + 32 * 512 + (t & 63) * 512 + (c - 512));
                            base = *(const f32x4*)(X + (size_t)row * 1024 + c) + pv; }
                        else base = *(const f32x4*)(O + (size_t)row * 1024 + c);
                        *(f32x4*)(O + (size_t)row * 1024 + c) = base + gt * acc[ai][bj][m][n]; }
                asm volatile("" ::: "memory"); }
    }
};

template <class Epi, class Sched, bool ALIGN_EPI = false, bool SP2 = false>
__device__ __forceinline__ void gemm_phase(PG8_LAS unsigned char* lds, const Gemm g, const Sched& S, const Epi& E) {
    const int tid = threadIdx.x, wid = __builtin_amdgcn_readfirstlane(tid >> 6), lane = tid & 63, wr = wid >> 2, wc = wid & 3, fr = lane & 15, fq = lane >> 4;
    const int K = g.K, nt = K / BK;
    unsigned voffA[2], voffB[2];
#pragma unroll
    for (int i = 0; i < 2; ++i) { int R, C; stage_rc(tid * 16 + i * 8192, R, C); const int Rb = Epi::PERM ? ((R & ~31) + perm32(R & 31)) : R;
        voffA[i] = (unsigned)(R * K + C) * 2u; voffB[i] = (unsigned)(Rb * K + C) * 2u; }
    const size_t kstep = (size_t)(BK * 2);
    const size_t hstep = (size_t)HALF * K * 2;
    const size_t tstep = 2 * hstep;
    const unsigned ldsw = (unsigned)wid * 1024u;
    const int aoff = lds_byte(wr * 64 + fr, fq * 8), boff = lds_byte(wc * 32 + fr, fq * 8);
#define PG8_SA(b, h) (((b) * 2 + (h)) * HTB)
#define PG8_SB(b, h) ((4 + (b) * 2 + (h)) * HTB)
#define PG8_STAGE(bufoff, gbase, voff) do { _Pragma("unroll") for (int _i = 0; _i < 2; ++_i) \
        __builtin_amdgcn_global_load_lds((const unsigned*)((const char*)(gbase) + (voff)[_i]), (PG8_LAS unsigned*)(lds + (bufoff) + ldsw + _i * 8192), 16, 0, 0); } while (0)
#define PG8_LDA(dst, b, h) do { _Pragma("unroll") for (int m = 0; m < 4; ++m) _Pragma("unroll") for (int k = 0; k < 2; ++k) dst[m][k] = *(const PG8_LAS bf16x8*)(lds + PG8_SA(b, h) + aoff + m * 2048 + k * 1024); } while (0)
#define PG8_LDB(dst, b, h) do { _Pragma("unroll") for (int n = 0; n < 2; ++n) _Pragma("unroll") for (int k = 0; k < 2; ++k) dst[n][k] = *(const PG8_LAS bf16x8*)(lds + PG8_SB(b, h) + boff + n * 2048 + k * 1024); } while (0)
#define PG8_MMA(ai, bj, At, Bt) do { __builtin_amdgcn_s_setprio(1); _Pragma("unroll") for (int m = 0; m < 4; ++m) _Pragma("unroll") for (int n = 0; n < 2; ++n) _Pragma("unroll") for (int k = 0; k < 2; ++k) \
        acc[ai][bj][m][n] = __builtin_amdgcn_mfma_f32_16x16x32_bf16(Bt[n][k], At[m][k], acc[ai][bj][m][n], 0, 0, 0); __builtin_amdgcn_s_setprio(0); } while (0)
#define PG8_WAIT_V(n) asm volatile("s_waitcnt vmcnt(" #n ")" ::: "memory")
#define PG8_WAIT_L(n) asm volatile("s_waitcnt lgkmcnt(" #n ")" ::: "memory")
#define PG8_BAR __builtin_amdgcn_s_barrier()
#define PG8_SCHED __builtin_amdgcn_sched_barrier(0)
    Unit cur, nxt; int ui = 0;
    if (!S.next(0, cur)) return;
    f32x4 acc[2][2][4][2];
#pragma unroll
    for (int a = 0; a < 2; ++a)
#pragma unroll
        for (int b = 0; b < 2; ++b)
#pragma unroll
            for (int m = 0; m < 4; ++m)
#pragma unroll
                for (int n = 0; n < 2; ++n) acc[a][b][m][n] = (f32x4){0.f, 0.f, 0.f, 0.f};
    bf16x8 At[4][2], B0[2][2], B1[2][2];
    const char* cA = (const char*)g.A + (size_t)cur.pm * tstep; const char* cB = (const char*)g.Bt + (size_t)cur.pn * tstep;
    S.a_ready(cur);
    if constexpr (SP2) {
        PG8_STAGE(PG8_SB(0, 0), cB, voffB); PG8_STAGE(PG8_SB(0, 1), cB + hstep, voffB); PG8_STAGE(PG8_SA(0, 0), cA, voffA); PG8_STAGE(PG8_SA(0, 1), cA + hstep, voffA);
        if (wr == 1) PG8_BAR;
        PG8_WAIT_V(2); PG8_BAR;
        PG8_STAGE(PG8_SB(1, 0), cB + kstep, voffB); PG8_STAGE(PG8_SA(1, 0), cA + kstep, voffA); PG8_STAGE(PG8_SB(1, 1), cB + hstep + kstep, voffB);
        PG8_WAIT_V(6); PG8_BAR;
    } else {
        PG8_STAGE(PG8_SB(0, 0), cB, voffB); PG8_STAGE(PG8_SA(0, 0), cA, voffA); PG8_STAGE(PG8_SB(0, 1), cB + hstep, voffB); PG8_STAGE(PG8_SA(0, 1), cA + hstep, voffA);
        if (wr == 1) PG8_BAR;
        PG8_WAIT_V(4); PG8_BAR;
        PG8_STAGE(PG8_SB(1, 0), cB + kstep, voffB); PG8_STAGE(PG8_SA(1, 0), cA + kstep, voffA); PG8_STAGE(PG8_SB(1, 1), cB + hstep + kstep, voffB);
        PG8_WAIT_V(6); PG8_BAR;
    }
    for (;;) {
        const bool has_next = S.next(ui + 1, nxt);
        const char* nA = has_next ? (const char*)g.A + (size_t)nxt.pm * tstep : cA; const char* nB = has_next ? (const char*)g.Bt + (size_t)nxt.pn * tstep : cB;
        for (int t = 0; t < nt; t += 2) {
            const bool last = (t == nt - 2);
            const char* a1 = cA + (size_t)(t + 1) * kstep;
            const char* a2 = last ? nA : cA + (size_t)(t + 2) * kstep; const char* b2 = last ? nB : cB + (size_t)(t + 2) * kstep;
            const char* a3 = a2 + kstep; const char* b3 = b2 + kstep;
            if (last && has_next) S.a_ready(nxt);
            if constexpr (SP2) {
            PG8_LDB(B0, 0, 0); PG8_LDB(B1, 0, 1); PG8_SCHED; PG8_LDA(At, 0, 0); PG8_STAGE(PG8_SA(1, 1), a1 + hstep, voffA);
            PG8_WAIT_V(8); PG8_WAIT_L(0); PG8_BAR; PG8_MMA(0, 0, At, B0); PG8_MMA(0, 1, At, B1); PG8_BAR; PG8_SCHED;
            PG8_LDA(At, 0, 1); PG8_STAGE(PG8_SB(0, 0), b2, voffB); PG8_STAGE(PG8_SB(0, 1), b2 + hstep, voffB); PG8_STAGE(PG8_SA(0, 0), a2, voffA);
            PG8_WAIT_V(8); PG8_WAIT_L(0); PG8_BAR; PG8_MMA(1, 0, At, B0); PG8_MMA(1, 1, At, B1); PG8_BAR; PG8_SCHED;
            PG8_LDB(B0, 1, 0); PG8_LDB(B1, 1, 1); PG8_SCHED; PG8_LDA(At, 1, 0); PG8_STAGE(PG8_SA(0, 1), a2 + hstep, voffA);
            PG8_WAIT_V(8); PG8_WAIT_L(0); PG8_BAR; PG8_MMA(0, 0, At, B0); PG8_MMA(0, 1, At, B1); PG8_BAR; PG8_SCHED;
            PG8_LDA(At, 1, 1); PG8_STAGE(PG8_SB(1, 0), b3, voffB); PG8_STAGE(PG8_SB(1, 1), b3 + hstep, voffB); PG8_STAGE(PG8_SA(1, 0), a3, voffA);
            PG8_WAIT_V(8); PG8_WAIT_L(0); PG8_BAR; PG8_MMA(1, 0, At, B0); PG8_MMA(1, 1, At, B1); PG8_BAR; PG8_SCHED;
            } else {
            PG8_LDB(B0, 0, 0); PG8_SCHED; PG8_LDA(At, 0, 0); PG8_STAGE(PG8_SA(1, 1), a1 + hstep, voffA);
            PG8_WAIT_L(8); PG8_BAR; PG8_WAIT_L(0); PG8_MMA(0, 0, At, B0); PG8_BAR; PG8_SCHED;
            PG8_LDB(B1, 0, 1); PG8_STAGE(PG8_SB(0, 0), b2, voffB);
            PG8_BAR; PG8_WAIT_L(0); PG8_MMA(0, 1, At, B1); PG8_BAR;
            PG8_LDA(At, 0, 1); PG8_STAGE(PG8_SA(0, 0), a2, voffA);
            PG8_BAR; PG8_WAIT_L(0); PG8_MMA(1, 0, At, B0); PG8_BAR; PG8_SCHED;
            PG8_STAGE(PG8_SB(0, 1), b2 + hstep, voffB);
            PG8_WAIT_V(6); PG8_BAR; PG8_MMA(1, 1, At, B1); PG8_BAR;
            PG8_LDB(B0, 1, 0); PG8_SCHED; PG8_LDA(At, 1, 0); PG8_STAGE(PG8_SA(0, 1), a2 + hstep, voffA);
            PG8_WAIT_L(8); PG8_BAR; PG8_WAIT_L(0); PG8_MMA(0, 0, At, B0); PG8_BAR; PG8_SCHED;
            PG8_LDB(B1, 1, 1); PG8_STAGE(PG8_SB(1, 0), b3, voffB);
            PG8_BAR; PG8_WAIT_L(0); PG8_MMA(0, 1, At, B1); PG8_BAR;
            PG8_LDA(At, 1, 1); PG8_STAGE(PG8_SA(1, 0), a3, voffA);
            PG8_BAR; PG8_WAIT_L(0); PG8_MMA(1, 0, At, B0); PG8_BAR; PG8_SCHED;
            PG8_STAGE(PG8_SB(1, 1), b3 + hstep, voffB);
            PG8_WAIT_V(6); PG8_BAR; PG8_MMA(1, 1, At, B1); PG8_BAR;
            }
        }
        if constexpr (ALIGN_EPI) { if (wr == 0) PG8_BAR; }
        if constexpr (!Epi::AFTER_DRAIN) { E(acc, cur, wr, wc, fr, fq); S.done(cur); }
        if (!has_next) break;
#pragma unroll
        for (int a = 0; a < 2; ++a)
#pragma unroll
            for (int b = 0; b < 2; ++b)
#pragma unroll
                for (int m = 0; m < 4; ++m)
#pragma unroll
                    for (int n = 0; n < 2; ++n) acc[a][b][m][n] = (f32x4){0.f, 0.f, 0.f, 0.f};
        cur = nxt; cA = nA; cB = nB; ++ui;
        if constexpr (ALIGN_EPI) { if (wr == 1) PG8_BAR; }
    }
    PG8_WAIT_V(0);
    if constexpr (!ALIGN_EPI) { if (wr == 0) PG8_BAR; }
    PG8_BAR;
    if constexpr (Epi::AFTER_DRAIN) { E.fused(acc, cur, wr, wc, fr, fq, lds, wid, lane); S.done(cur); }
#undef PG8_SA
#undef PG8_SB
#undef PG8_STAGE
#undef PG8_LDA
#undef PG8_LDB
#undef PG8_MMA
#undef PG8_WAIT_V
#undef PG8_WAIT_L
#undef PG8_BAR
#undef PG8_SCHED
}
}
#define PG8_SP2 true

constexpr int NWAVES = 8;
#ifndef MK_N_LAUNCHES
#define MK_N_LAUNCHES 1
#endif
constexpr int N_PHASES = 12;
constexpr int N_LAUNCHES = MK_N_LAUNCHES;

constexpr int NB = 8, T = 2048, D = 1024, M = NB * T, CT = 256, MC = NB * CT, FW = 512, FF = 4096, NMOD = 6 * D;
constexpr float EPS = 1e-6f;

constexpr size_t MiB = 1u << 20;
constexpr size_t WS_CTL = 0, CTL_ZERO_BYTES = 64 * 1024;
constexpr size_t WS_MODF = 1 * MiB;
constexpr size_t WS_POS = 1 * MiB + 256 * 1024;
constexpr size_t WS_WIN = 2 * MiB;
constexpr size_t WS_W1 = 12 * MiB, WS_W2 = 20 * MiB, WS_WOUT = 28 * MiB, WS_WL = 30 * MiB, WS_WF = 32 * MiB, WS_WG = 33 * MiB;
constexpr size_t WS_HCTX = 34 * MiB, WS_UXC = 38 * MiB;
constexpr size_t WS_HLAT = 48 * MiB;
constexpr size_t WS_UX = 80 * MiB;
constexpr size_t WS_PQT = 112 * MiB;
constexpr size_t WS_YF = 144 * MiB;
constexpr size_t WS_DFTM = 160 * MiB;
constexpr size_t WS_HID = 48 * MiB;
constexpr size_t WS_UY = 176 * MiB;
constexpr size_t WS_YB = 208 * MiB;
constexpr size_t WS_END = 240 * MiB;
constexpr int CW_BAR = 1024;

constexpr int RING_OFF = 0, RING_BYTES = 131072;
constexpr int LDSCTL_OFF = RING_BYTES, MISC_OFF = LDSCTL_OFF + 320;
constexpr int LDS_BYTES = 147456;
static_assert(MISC_OFF + 128 <= LDS_BYTES, "LDS map");

#define GAS __attribute__((address_space(1)))
#define LAS __attribute__((address_space(3)))
typedef unsigned short bf16;
typedef unsigned v4u __attribute__((ext_vector_type(4)));
typedef unsigned v2u __attribute__((ext_vector_type(2)));
typedef float f32x4 __attribute__((ext_vector_type(4)));
typedef float f32x16 __attribute__((ext_vector_type(16)));
typedef short bf16x8 __attribute__((ext_vector_type(8)));
typedef GAS unsigned gu32;
#define RLX_AGENT __ATOMIC_RELAXED, __HIP_MEMORY_SCOPE_AGENT
#define LDS_WAIT() asm volatile("s_waitcnt lgkmcnt(0)" ::: "memory")
#define VM_WAIT() asm volatile("s_waitcnt vmcnt(0)" ::: "memory")
#define CBAR() asm volatile("" ::: "memory")
__device__ __forceinline__ unsigned f2bf(float f) { unsigned u = __builtin_bit_cast(unsigned, f); return (u + 0x7fffu + ((u >> 16) & 1u)) >> 16; }
__device__ __forceinline__ unsigned pk2(float lo, float hi) { return f2bf(lo) | (f2bf(hi) << 16); }
__device__ __forceinline__ float bflo(unsigned w) { return __uint_as_float(w << 16); }
__device__ __forceinline__ float bfhi(unsigned w) { return __uint_as_float(w & 0xffff0000u); }
__device__ __forceinline__ float bf1(unsigned short h) { return __uint_as_float(((unsigned)h) << 16); }

#define XB_TMO      128
#define XB_XCNT(j)  (256  + 64 * (j))
#define XB_XSUB(j)  (1280 + 64 * (j))
#define XB_XGEN(j)  (2304 + 64 * (j))
#define XB_TOP      3328
#define XB_TOPGEN   3392
#define XCD_BAR_WORDS 3456
#define XB_SPIN_CAP (1u << 18)

__device__ __forceinline__ unsigned xb_ld(unsigned* p)              { return __hip_atomic_load(p, __ATOMIC_RELAXED, __HIP_MEMORY_SCOPE_AGENT); }
__device__ __forceinline__ unsigned xb_add(unsigned* p, unsigned v) { return __hip_atomic_fetch_add(p, v, __ATOMIC_RELAXED, __HIP_MEMORY_SCOPE_AGENT); }
__device__ __forceinline__ unsigned xb_xcc_id() { return (unsigned)__builtin_amdgcn_s_getreg((3 << 11) | 20) & 0xFu; }
#define XB_SPIN(cond, bar) do { unsigned _sp = 0; while (cond) { __builtin_amdgcn_s_sleep(1); \
    if ((++_sp & 255u) == 0u) { if (xb_ld(&(bar)[XB_TMO])) break; if (_sp > XB_SPIN_CAP) { atomicAdd(&(bar)[XB_TMO], 1u); break; } } } } while (0)

struct XcdBarrier {
    unsigned* bar; unsigned x;
    volatile LAS unsigned* st;
};

__device__ __forceinline__ XcdBarrier xcd_barrier_post(unsigned* bar, volatile LAS unsigned* st) {
    XcdBarrier b; b.bar = bar; b.x = xb_xcc_id(); b.st = st;
    if (threadIdx.x == 0) (void)xb_add(&bar[XB_XCNT(b.x)], 1u);
    return b;
}
__device__ __forceinline__ void xcd_barrier_complete(unsigned* bar, unsigned x, unsigned& nloc, unsigned& nx) {
    const unsigned G = gridDim.x * gridDim.y * gridDim.z;
    unsigned sum, cnt, mine, sp = 0u;
    for (;;) {
        sum = 0u; cnt = 0u; mine = 0u;
#pragma unroll
        for (unsigned j = 0; j < 16; ++j) { const unsigned c = xb_ld(&bar[XB_XCNT(j)]); sum += c; cnt += (c > 0u) ? 1u : 0u; mine = (j == x) ? c : mine; }
        if (sum == G) break;
        __builtin_amdgcn_s_sleep(1);
        if ((++sp & 255u) == 0u) { if (xb_ld(&bar[XB_TMO])) break; if (sp > XB_SPIN_CAP) { atomicAdd(&bar[XB_TMO], 1u); break; } }
    }
    nloc = mine > 0u ? mine : 1u; nx = cnt > 0u ? cnt : 1u;
}

__device__ __forceinline__ void xcd_barrier(const XcdBarrier& b) {
    asm volatile("s_waitcnt vmcnt(0)" ::: "memory");
    __syncthreads();
    if (threadIdx.x == 0) {
        unsigned* bar = b.bar;
        __builtin_amdgcn_s_waitcnt(0);
        unsigned nloc = b.st[0], nx = b.st[1];
        if (nloc == 0u) { xcd_barrier_complete(bar, b.x, nloc, nx); b.st[0] = nloc; b.st[1] = nx; }
        const unsigned old = xb_add(&bar[XB_XSUB(b.x)], 1u);
        const unsigned gen = old / nloc;
        if (old + 1u == (gen + 1u) * nloc) {
            __builtin_amdgcn_fence(__ATOMIC_RELEASE, "agent");
            asm volatile("s_waitcnt vmcnt(0)" ::: "memory");
            const unsigned og = xb_add(&bar[XB_TOP], 1u);
            const unsigned tg = og / nx;
            if (og + 1u == (tg + 1u) * nx) xb_add(&bar[XB_TOPGEN], 1u);
            else XB_SPIN(xb_ld(&bar[XB_TOPGEN]) == tg, bar);
            __builtin_amdgcn_fence(__ATOMIC_ACQUIRE, "agent");
            xb_add(&bar[XB_XGEN(b.x)], 1u);
            asm volatile("s_waitcnt vmcnt(0)" ::: "memory");
        } else {
            XB_SPIN(xb_ld(&bar[XB_XGEN(b.x)]) == gen, bar);
            __builtin_amdgcn_fence(__ATOMIC_ACQUIRE, "agent");
            asm volatile("s_waitcnt vmcnt(0)" ::: "memory");
        }
    }
    __syncthreads();
}

struct Frame {
    LAS unsigned char* lds;
    volatile LAS unsigned* MISC;
    gu32* ctl;
    int tid, lane, wave;
    int vcu, G;
    const float *x, *c, *ctx, *c_ctx, *w_mod, *b_mod, *g_mix, *w_in, *conv_w, *conv_b, *w_a, *b_a, *w_x, *b_x, *lam, *w_lru_out, *w_f_out, *w_out, *g_mlp, *w1, *w2, *g_final;
    float* out;
    float *MODF, *POS;
    bf16 *WIN, *W1T, *W2T, *WOUT, *WL, *WF, *WG, *HCTX, *UXC, *HLAT, *UX, *PQT, *YF, *DFTM, *HID, *UY, *YB, *UG;
};

__device__ __forceinline__ float wave_sum(float v) {
#pragma unroll
    for (int o = 1; o < 64; o <<= 1) v += __shfl_xor(v, o);
    return v;
}
__device__ __forceinline__ float sigm(float x) { return __builtin_amdgcn_rcpf(1.0f + __expf(-x)); }

__device__ __forceinline__ void p0_transpose_item(const float* W, int K, int ldw, int col0, int nblk, bf16* WT, int row_off, LAS float* scr, int item, int lane) {
    const int kb = item / nblk, nb = item % nblk, k0 = 64 * kb, n0 = 32 * nb;
#pragma unroll 8
    for (int i = 0; i < 32; ++i) { const int kk = 2 * i + (lane >> 5); scr[kk * 33 + (lane & 31)] = W[(size_t)(k0 + kk) * ldw + col0 + n0 + (lane & 31)]; }
    LDS_WAIT(); CBAR();
    const int c = lane & 7;
#pragma unroll
    for (int j = 0; j < 4; ++j) { const int n = (lane >> 3) + 8 * j; const LAS float* s = scr + (8 * c) * 33 + n;
        v4u o; o.x = pk2(s[0 * 33], s[1 * 33]); o.y = pk2(s[2 * 33], s[3 * 33]); o.z = pk2(s[4 * 33], s[5 * 33]); o.w = pk2(s[6 * 33], s[7 * 33]);
        *(v4u*)(WT + (size_t)(row_off + n0 + n) * K + k0 + 8 * c) = o; }
    LDS_WAIT(); CBAR();
}

__device__ __forceinline__ void p0_prologue(Frame& F) {
    LAS float* sc = (LAS float*)(F.lds);
    LAS float* red = (LAS float*)(F.lds + 36864);
    LAS float* trig = (LAS float*)(F.lds + 49152);
    for (int idx = F.tid; idx < 9 * 1024; idx += NWAVES * 64) { const int r = idx >> 10, k = idx & 1023; const float v = (r < 8) ? F.c[r * 1024 + k] : F.c_ctx[k]; sc[idx] = v * sigm(v); }
    if (F.tid < 128) { float s, c; sincospif((float)F.tid * (1.0f / 64.0f), &s, &c); trig[F.tid] = c; trig[128 + F.tid] = s; }
    __syncthreads();
    for (int item = F.vcu; item < NMOD / 32; item += F.G) {
        const int n0 = item * 32, kh = F.lane >> 5, nl = F.lane & 31;
        float acc[9];
#pragma unroll
        for (int r = 0; r < 9; ++r) acc[r] = 0.f;
#pragma unroll 8
        for (int i = 0; i < 64; ++i) { const int k = F.wave * 128 + 2 * i + kh; const float w = F.w_mod[(size_t)k * NMOD + n0 + nl];
#pragma unroll
            for (int r = 0; r < 9; ++r) acc[r] += sc[r * 1024 + k] * w; }
#pragma unroll
        for (int r = 0; r < 9; ++r) acc[r] += __shfl_xor(acc[r], 32);
        if (F.lane < 32) {
#pragma unroll
            for (int r = 0; r < 9; ++r) red[(F.wave * 9 + r) * 32 + nl] = acc[r]; }
        __syncthreads();
        if (F.tid < 288) { const int r = F.tid >> 5, n = F.tid & 31; float s = F.b_mod[n0 + n];
#pragma unroll
            for (int w = 0; w < 8; ++w) s += red[(w * 9 + r) * 32 + n];
            F.MODF[r * NMOD + n0 + n] = s; }
        __syncthreads();
    }
    LAS float* scr = (LAS float*)(F.lds + 53248 + F.wave * 8704);
    const int gw = F.vcu * NWAVES + F.wave, NGW = F.G * NWAVES;
    constexpr int I_IN1 = 16 * 64, I_IN2 = 16 * 64, I_W1 = 16 * 128, I_W2 = 64 * 32, I_WO = 16 * 32, I_WLR = 16 * 32, I_WF = 8 * 32, I_G = 16 * 8;
    constexpr int I_PQ = 4 * 2 * 8 * 16, I_POS = 96, I_DFT = 2048;
    constexpr int NITEMS = I_IN1 + I_IN2 + I_W1 + I_W2 + I_WO + I_WLR + I_WF + 2 * I_G + I_PQ + I_POS + I_DFT;
    for (int it = gw; it < NITEMS; it += NGW) {
        int r = it;
        if (r < I_IN1) { p0_transpose_item(F.w_in, 1024, 4608, 0, 64, F.WIN, 0, scr, r, F.lane); continue; } r -= I_IN1;
        if (r < I_IN2) { p0_transpose_item(F.w_in, 1024, 4608, 2560, 64, F.WIN, 2048, scr, r, F.lane); continue; } r -= I_IN2;
        if (r < I_W1) { p0_transpose_item(F.w1, 1024, 4096, 0, 128, F.W1T, 0, scr, r, F.lane); continue; } r -= I_W1;
        if (r < I_W2) { p0_transpose_item(F.w2, 4096, 1024, 0, 32, F.W2T, 0, scr, r, F.lane); continue; } r -= I_W2;
        if (r < I_WO) { p0_transpose_item(F.w_out, 1024, 1024, 0, 32, F.WOUT, 0, scr, r, F.lane); continue; } r -= I_WO;
        if (r < I_WLR) { p0_transpose_item(F.w_lru_out, 1024, 1024, 0, 32, F.WL, 0, scr, r, F.lane); continue; } r -= I_WLR;
        if (r < I_WF) { p0_transpose_item(F.w_f_out, 512, 1024, 0, 32, F.WF, 0, scr, r, F.lane); continue; } r -= I_WF;
        if (r < I_G) { const int mat = r >> 3;
            p0_transpose_item(F.w_a + (size_t)mat * 16384, 128, 128, 0, 4, F.WG, mat * 256, scr, r & 7, F.lane); continue; } r -= I_G;
        if (r < I_G) { const int mat = r >> 3;
            p0_transpose_item(F.w_x + (size_t)mat * 16384, 128, 128, 0, 4, F.WG, mat * 256 + 128, scr, r & 7, F.lane); continue; } r -= I_G;
        if (r < I_PQ) {
            const int kc = r & 15, mc = (r >> 4) & 7, pq = (r >> 7) & 1, g = r >> 8;
            const int k = kc * 64 + F.lane, m0 = mc * 16;
            const float* wrow = F.w_in + (size_t)k * 4608 + 2048 + g * 128;
            const LAS float* tg = trig + pq * 128;
            float acc[16];
#pragma unroll
            for (int mm = 0; mm < 16; ++mm) acc[mm] = 0.f;
            for (int c4 = 0; c4 < 32; ++c4) { const f32x4 w4 = *(const f32x4*)(wrow + 4 * c4);
#pragma unroll
                for (int cc = 0; cc < 4; ++cc) { const int c = 4 * c4 + cc;
#pragma unroll
                    for (int mm = 0; mm < 16; ++mm) acc[mm] += tg[((m0 + mm) * c) & 127] * w4[cc]; } }
#pragma unroll
            for (int mm = 0; mm < 16; ++mm) F.WIN[(size_t)(4096 + pq * 512 + g * 128 + m0 + mm) * 1024 + k] = (bf16)f2bf(acc[mm] * (1.0f / 512.0f));
            continue; } r -= I_PQ;
        if (r < I_POS) {
            const float p = (float)(r < 32 ? r : r - 32);
#pragma unroll
            for (int j = 0; j < 8; ++j) { const int ch = j * 64 + F.lane, i = ch & 255;
                const float freq = expf(-9.210340371976184f * (float)i / 256.0f); const float ang = p * freq;
                float s, c; sincospif(ang * 0.3183098861837907f, &s, &c);
                F.POS[r * 512 + ch] = (ch < 256) ? s : c; }
            continue; } r -= I_POS;
        {
            const int k = r;
#pragma unroll 1
            for (int q = 0; q < 8; ++q) { const int col0 = (q * 64 + F.lane) * 8; float v[8];
#pragma unroll
                for (int j = 0; j < 8; ++j) { const int col = col0 + j, t = col & 2047; const int ph = (k * t) & 2047; float s, c; sincospif((float)ph * (1.0f / 1024.0f), &s, &c); v[j] = (col < 2048) ? c : -s; }
                v4u o; o.x = pk2(v[0], v[1]); o.y = pk2(v[2], v[3]); o.z = pk2(v[4], v[5]); o.w = pk2(v[6], v[7]);
                *(v4u*)(F.DFTM + (size_t)k * 4096 + col0) = o; }
        }
    }
}

template <int MODE> __device__ __forceinline__ void norm_rows(Frame& F) {
    const int gw = F.vcu * NWAVES + F.wave, NGW = F.G * NWAVES;
    const int nrows = (MODE == 0) ? (M + MC) : M;
    const float* gvec = (MODE == 0) ? F.g_mix : (MODE == 1 ? F.g_mlp : F.g_final);
    f32x4 g[4];
#pragma unroll
    for (int j = 0; j < 4; ++j) g[j] = *(const f32x4*)(gvec + 256 * j + 4 * F.lane);
    for (int row = gw; row < nrows; row += NGW) {
        const bool lat = row < M;
        const float* src = (MODE == 0) ? (lat ? F.x + (size_t)row * D : F.ctx + (size_t)(row - M) * D) : F.out + (size_t)row * D;
        f32x4 v[4]; float ss = 0.f;
#pragma unroll
        for (int j = 0; j < 4; ++j) v[j] = *(const f32x4*)(src + 256 * j + 4 * F.lane);
        if (MODE == 0 && lat) { const int t = row & (T - 1);
#pragma unroll
            for (int j = 0; j < 4; ++j) { const int c = 256 * j + 4 * F.lane;
                const f32x4 pv = (j < 2) ? *(const f32x4*)(F.POS + (t >> 6) * 512 + c) : *(const f32x4*)(F.POS + 32 * 512 + (t & 63) * 512 + (c - 512));
                v[j] = v[j] + pv; } }
#pragma unroll
        for (int j = 0; j < 4; ++j) ss += (v[j].x * v[j].x + v[j].y * v[j].y) + (v[j].z * v[j].z + v[j].w * v[j].w);
        const float rstd = 1.0f / sqrtf(wave_sum(ss) * (1.0f / D) + EPS);
        if (MODE == 2) {
#pragma unroll
            for (int j = 0; j < 4; ++j) *(f32x4*)(F.out + (size_t)row * D + 256 * j + 4 * F.lane) = v[j] * rstd * g[j];
        } else {
            const int mrow = lat ? (row >> 11) : 8;
            const float* mod = F.MODF + (size_t)mrow * NMOD + (MODE == 0 ? 0 : 3072);
            bf16* dst = (MODE == 0) ? (lat ? F.HLAT + (size_t)row * D : F.HCTX + (size_t)(row - M) * D) : F.UY + (size_t)row * D;
#pragma unroll
            for (int j = 0; j < 4; ++j) { const int c = 256 * j + 4 * F.lane;
                const f32x4 sh = *(const f32x4*)(mod + c), scl = *(const f32x4*)(mod + 1024 + c);
                const f32x4 h = v[j] * rstd * g[j] * (scl + 1.0f) + sh;
                v2u o; o.x = pk2(h.x, h.y); o.y = pk2(h.z, h.w);
                *(v2u*)(dst + c) = o; }
        }
    }
}

constexpr int SC_TILE = 8704;
constexpr int SC_CONVW = 8 * SC_TILE;
constexpr int SC_TAB = SC_CONVW + 2560;
template <int DIR>
__device__ __forceinline__ void scan_pass(Frame& F, int b, int hd, int q, float& carry, int& round) {
    const int lane = F.lane, w = F.wave, h = lane >> 5, cl = lane & 31;
    LAS unsigned char* tile = F.lds + w * SC_TILE;
    const LAS float* cwl = (const LAS float*)(F.lds + SC_CONVW);
    LAS float* tab = (LAS float*)(F.lds + SC_TAB);
    const int ch = hd * 128 + q * 32 + cl;
    const float ba = F.b_a[DIR * 1024 + ch], bx = F.b_x[DIR * 1024 + ch];
    const float nsp8 = -8.0f * log1pf(expf(-F.lam[DIR * 1024 + ch]));
    bf16x8 Bf[2][8];
#pragma unroll
    for (int g = 0; g < 2; ++g)
#pragma unroll
        for (int ks = 0; ks < 8; ++ks) Bf[g][ks] = *(const bf16x8*)(F.WG + ((size_t)((DIR * 8 + hd) * 256 + g * 128 + q * 32 + cl)) * 128 + ks * 16 + 8 * h);
    const int rs = lane >> 4, ck = lane & 15;
#pragma unroll 1
    for (int seg = 0; seg < 2; ++seg) {
        const int Tseg = seg ? T : CT;
        const bf16* segp = seg ? F.UX + (size_t)b * T * D : F.UXC + (size_t)b * CT * D;
        const int nrounds = (Tseg + 511) / 512;
#pragma unroll 1
        for (int ri = 0; ri < nrounds; ++ri) {
            const int r0 = (DIR == 0 ? ri : nrounds - 1 - ri) * 512;
            const int nact = (Tseg - r0) >= 512 ? 8 : (Tseg - r0) / 64;
            const bool active = w < nact;
            const int t0 = r0 + 64 * w;
            float av[2][16], bv[2][16];
            float preA[8], preH[8];
            if (active) {
#pragma unroll
                for (int mt = 0; mt < 2; ++mt) {
                    {
                        v4u v[11];
#pragma unroll
                        for (int i = 0; i < 11; ++i) { const int tt = t0 + 32 * mt + rs * 8 - 2 + i;
                            v[i] = (tt >= 0 && tt < Tseg) ? *(const v4u*)(segp + (size_t)tt * D + hd * 128 + ck * 8) : (v4u){0u, 0u, 0u, 0u}; }
                        f32x4 cw[4][2], cb[2];
#pragma unroll
                        for (int k = 0; k < 4; ++k) { cw[k][0] = *(const LAS f32x4*)(cwl + k * 128 + ck * 8); cw[k][1] = *(const LAS f32x4*)(cwl + k * 128 + ck * 8 + 4); }
                        cb[0] = *(const LAS f32x4*)(cwl + 512 + ck * 8); cb[1] = *(const LAS f32x4*)(cwl + 512 + ck * 8 + 4);
#pragma unroll
                        for (int o = 0; o < 8; ++o) { f32x4 x0 = cb[0], x1 = cb[1];
#pragma unroll
                            for (int k = 0; k < 4; ++k) { const v4u u = v[o + k];
                                x0[0] += cw[k][0][0] * bflo(u.x); x0[1] += cw[k][0][1] * bfhi(u.x); x0[2] += cw[k][0][2] * bflo(u.y); x0[3] += cw[k][0][3] * bfhi(u.y);
                                x1[0] += cw[k][1][0] * bflo(u.z); x1[1] += cw[k][1][1] * bfhi(u.z); x1[2] += cw[k][1][2] * bflo(u.w); x1[3] += cw[k][1][3] * bfhi(u.w); }
                            v4u o4; o4.x = pk2(x0[0], x0[1]); o4.y = pk2(x0[2], x0[3]); o4.z = pk2(x1[0], x1[1]); o4.w = pk2(x1[2], x1[3]);
                            *(LAS v4u*)(tile + (rs * 8 + o) * 272 + ck * 16) = o4; }
                    }
                    CBAR();
                    f32x16 accr, acci;
#pragma unroll
                    for (int i = 0; i < 16; ++i) { accr[i] = 0.f; acci[i] = 0.f; }
#pragma unroll
                    for (int ks = 0; ks < 8; ++ks) { const bf16x8 af = *(const LAS bf16x8*)(tile + cl * 272 + (ks * 16 + 8 * h) * 2);
                        accr = __builtin_amdgcn_mfma_f32_32x32x16_bf16(af, Bf[0][ks], accr, 0, 0, 0);
                        acci = __builtin_amdgcn_mfma_f32_32x32x16_bf16(af, Bf[1][ks], acci, 0, 0, 0); }
#pragma unroll
                    for (int reg = 0; reg < 16; ++reg) { const int row = (reg & 3) + 8 * (reg >> 2) + 4 * h;
                        const float xc = bf1(*(const LAS unsigned short*)(tile + row * 272 + (q * 32 + cl) * 2));
                        const float rg = sigm(accr[reg] + ba), ig = sigm(acci[reg] + bx);
                        const float la = nsp8 * rg; const float a = __expf(la);
                        const float x2 = 2.0f * la;
                        const float ser = -x2 * (1.0f + x2 * 0.5f * (1.0f + x2 * (1.0f / 3.0f) * (1.0f + x2 * 0.25f * (1.0f + x2 * 0.2f * (1.0f + x2 * (1.0f / 6.0f))))));
                        const float m2 = (x2 > -0.25f) ? ser : (1.0f - a * a);
                        av[mt][reg] = a; bv[mt][reg] = sqrtf(m2) * ig * xc; }
                    CBAR();
                }
                float gA[8], gH[8];
#pragma unroll
                for (int mt = 0; mt < 2; ++mt)
#pragma unroll
                    for (int g4 = 0; g4 < 4; ++g4) { float ar = 1.f, hr = 0.f;
#pragma unroll
                        for (int ii = 0; ii < 4; ++ii) { const int i = g4 * 4 + (DIR == 0 ? ii : 3 - ii);
                            hr = av[mt][i] * hr + bv[mt][i]; ar = ar * av[mt][i]; av[mt][i] = ar; bv[mt][i] = hr; }
                        gA[mt * 4 + g4] = ar; gH[mt * 4 + g4] = hr; }
                float pA[8], pH[8];
#pragma unroll
                for (int gi = 0; gi < 8; ++gi) { pA[gi] = __shfl_xor(gA[gi], 32); pH[gi] = __shfl_xor(gH[gi], 32); }
                float Ar = 1.f, Hr = 0.f;
#pragma unroll
                for (int gg = 0; gg < 8; ++gg) { const int gi = (DIR == 0) ? gg : 7 - gg;
                    const bool own_first = (DIR == 0) ? (h == 0) : (h == 1);
                    const float fA = own_first ? gA[gi] : pA[gi], fH = own_first ? gH[gi] : pH[gi];
                    const float sA = own_first ? pA[gi] : gA[gi], sH = own_first ? pH[gi] : gH[gi];
                    const float Ar1 = fA * Ar, Hr1 = fA * Hr + fH;
                    preA[gi] = own_first ? Ar : Ar1; preH[gi] = own_first ? Hr : Hr1;
                    Ar = sA * Ar1; Hr = sA * Hr1 + sH; }
                if (lane < 32) { tab[((round & 1) * 8 + w) * 64 + cl] = Ar; tab[((round & 1) * 8 + w) * 64 + 32 + cl] = Hr; }
            }
            __syncthreads();
            float my = carry; { float c = carry;
#pragma unroll
                for (int ww = 0; ww < 8; ++ww) { const int w2 = (DIR == 0) ? ww : 7 - ww;
                    if (w2 < nact) { if (w2 == w) my = c; c = tab[((round & 1) * 8 + w2) * 64 + cl] * c + tab[((round & 1) * 8 + w2) * 64 + 32 + cl]; } }
                carry = c; }
            ++round;
            if (active && seg == 1) {
#pragma unroll
                for (int mt = 0; mt < 2; ++mt)
#pragma unroll
                    for (int reg = 0; reg < 16; ++reg) { const int gi = mt * 4 + (reg >> 2);
                        const float gc = preH[gi] + preA[gi] * my;
                        const float hv = bv[mt][reg] + av[mt][reg] * gc;
                        const int tok = t0 + 32 * mt + 8 * (reg >> 2) + 4 * h + (reg & 3);
                        const size_t idx = ((size_t)b * T + tok) * D + ch;
                        if (DIR == 0) F.HLAT[idx] = (bf16)f2bf(hv);
                        else { const float y = (bf1(F.HLAT[idx]) + hv) * bf1(F.UY[idx]); F.UY[idx] = (bf16)f2bf(y); } }
            }
        }
    }
}
__device__ __forceinline__ void scan_phase(Frame& F) {
    int round = 0;
    for (int item = F.vcu; item < NB * 8 * 4; item += F.G) {
        const int q = item & 3, hd = (item >> 2) & 7, b = item >> 5;
        LAS float* cwl = (LAS float*)(F.lds + SC_CONVW);
        for (int i = F.tid; i < 640; i += NWAVES * 64) { const int k = i >> 7, c = i & 127; cwl[i] = (k < 4) ? F.conv_w[k * 1024 + hd * 128 + c] : F.conv_b[hd * 128 + c]; }
        __syncthreads();
        float carry = 0.f;
        scan_pass<0>(F, b, hd, q, carry, round);
        VM_WAIT(); __syncthreads();
        carry = 0.f;
        scan_pass<1>(F, b, hd, q, carry, round);
        __syncthreads();
    }
}

struct Args { const float* in[22]; float* out; unsigned char* ws; int ph_lo, ph_hi; };
__global__ void __launch_bounds__(NWAVES * 64, 2) mk_fwd(Args args) {
    extern __shared__ __attribute__((aligned(16))) unsigned char lds[];
    Frame F;
    F.lds = (LAS unsigned char*)lds;
    F.MISC = (volatile LAS unsigned*)(F.lds + MISC_OFF);
    F.tid = threadIdx.x; F.lane = F.tid & 63; F.wave = __builtin_amdgcn_readfirstlane(F.tid >> 6);
    F.G = gridDim.x; { const int bx = blockIdx.x; F.vcu = (F.G % 8 == 0) ? (bx % 8) * (F.G / 8) + bx / 8 : bx; }
    unsigned char* ws = args.ws;
    F.ctl = (gu32*)(ws + WS_CTL);
    F.x = args.in[0]; F.c = args.in[1]; F.ctx = args.in[2]; F.c_ctx = args.in[3]; F.w_mod = args.in[4]; F.b_mod = args.in[5]; F.g_mix = args.in[6]; F.w_in = args.in[7];
    F.conv_w = args.in[8]; F.conv_b = args.in[9]; F.w_a = args.in[10]; F.b_a = args.in[11]; F.w_x = args.in[12]; F.b_x = args.in[13]; F.lam = args.in[14];
    F.w_lru_out = args.in[15]; F.w_f_out = args.in[16]; F.w_out = args.in[17]; F.g_mlp = args.in[18]; F.w1 = args.in[19]; F.w2 = args.in[20]; F.g_final = args.in[21];
    F.out = args.out;
    F.MODF = (float*)(ws + WS_MODF); F.POS = (float*)(ws + WS_POS);
    F.WIN = (bf16*)(ws + WS_WIN); F.W1T = (bf16*)(ws + WS_W1); F.W2T = (bf16*)(ws + WS_W2); F.WOUT = (bf16*)(ws + WS_WOUT); F.WL = (bf16*)(ws + WS_WL); F.WF = (bf16*)(ws + WS_WF); F.WG = (bf16*)(ws + WS_WG);
    F.HCTX = (bf16*)(ws + WS_HCTX); F.UXC = (bf16*)(ws + WS_UXC); F.HLAT = (bf16*)(ws + WS_HLAT); F.UX = (bf16*)(ws + WS_UX); F.PQT = (bf16*)(ws + WS_PQT); F.YF = (bf16*)(ws + WS_YF);
    F.DFTM = (bf16*)(ws + WS_DFTM); F.HID = (bf16*)(ws + WS_HID); F.UY = (bf16*)(ws + WS_UY); F.YB = (bf16*)(ws + WS_YB); F.UG = (bf16*)args.out;
    for (int u = F.tid; u < (LDS_BYTES - LDSCTL_OFF) / 4; u += NWAVES * 64) ((LAS unsigned*)(F.lds + LDSCTL_OFF))[u] = 0u;
    __syncthreads();
    const bool one_launch = (args.ph_hi - args.ph_lo) > 1;
    XcdBarrier bar; bar.bar = (unsigned*)(F.ctl + CW_BAR); bar.x = 0; bar.st = nullptr;
    if (one_launch) bar = xcd_barrier_post((unsigned*)(F.ctl + CW_BAR), F.MISC + 8);
    const int lo = args.ph_lo, hi = args.ph_hi;
#define IN(k) (lo <= (k) && (k) < hi)
#define SEAM(k) do { if (IN(k) && IN((k) + 1)) xcd_barrier(bar); } while (0)
    using pg8::Gemm; using pg8::StaticOrder;
    const int cid = (int)blockIdx.x;

    if (IN(0)) { p0_prologue(F); SEAM(0); }
    if (IN(1)) { norm_rows<0>(F); SEAM(1); }
    if (IN(2)) {
        { Gemm g{F.HLAT, F.WIN, M, 4096, D}; StaticOrder S; S.init(M, 4096, F.G, cid); pg8::EpiInMain E{F.UX, F.UY, F.UG};
          pg8::gemm_phase<pg8::EpiInMain, StaticOrder, true, true>(F.lds + RING_OFF, g, S, E); }
        { Gemm g{F.WIN + (size_t)4096 * D, F.HLAT, 1024, M, D}; StaticOrder S; S.init(1024, M, F.G, cid); pg8::EpiPQT E{F.PQT};
          pg8::gemm_phase<pg8::EpiPQT, StaticOrder, true, true>(F.lds + RING_OFF, g, S, E); }
        { Gemm g{F.HCTX, F.WIN, MC, 1024, D}; StaticOrder S; S.init(MC, 1024, F.G, cid); pg8::EpiBf16<0> E{F.UXC, D};
          pg8::gemm_phase<pg8::EpiBf16<0>, StaticOrder, true, true>(F.lds + RING_OFF, g, S, E); }
        SEAM(2);
    }
    if (IN(3)) { scan_phase(F); SEAM(3); }
    if (IN(4)) {
        Gemm g{F.DFTM, F.PQT, T, NB * FW, 2 * T}; StaticOrder S; S.init(T, NB * FW, F.G, cid); pg8::EpiDft E{F.YF};
        pg8::gemm_phase<pg8::EpiDft, StaticOrder, true, true>(F.lds + RING_OFF, g, S, E);
        SEAM(4);
    }
    if (IN(5)) {
        Gemm g{F.YF, F.WF, M, D, FW}; StaticOrder S; S.init(M, D, F.G, cid); pg8::EpiGate<false> E{F.YB, D, F.UG + 1024, 2048, nullptr};
        pg8::gemm_phase<pg8::EpiGate<false>, StaticOrder, true, true>(F.lds + RING_OFF, g, S, E);
        SEAM(5);
    }
    if (IN(6)) {
        Gemm g{F.UY, F.WL, M, D, D}; StaticOrder S; S.init(M, D, F.G, cid); pg8::EpiGate<true> E{F.UX, D, F.UG, 2048, F.YB};
        pg8::gemm_phase<pg8::EpiGate<true>, StaticOrder, true, true>(F.lds + RING_OFF, g, S, E);
        SEAM(6);
    }
    if (IN(7)) {
        Gemm g{F.UX, F.WOUT, M, D, D}; StaticOrder S; S.init(M, D, F.G, cid); pg8::EpiResid<0> E{F.x, F.out, F.MODF + 2048, F.POS};
        pg8::gemm_phase<pg8::EpiResid<0>, StaticOrder, true, true>(F.lds + RING_OFF, g, S, E);
        SEAM(7);
    }
    if (IN(8)) { norm_rows<1>(F); SEAM(8); }
    if (IN(9)) {
        Gemm g{F.UY, F.W1T, M, FF, D}; StaticOrder S; S.init(M, FF, F.G, cid); pg8::EpiBf16<1> E{F.HID, FF};
        pg8::gemm_phase<pg8::EpiBf16<1>, StaticOrder, true, true>(F.lds + RING_OFF, g, S, E);
        SEAM(9);
    }
    if (IN(10)) {
        Gemm g{F.HID, F.W2T, M, D, FF}; StaticOrder S; S.init(M, D, F.G, cid); pg8::EpiResid<1> E{nullptr, F.out, F.MODF + 5120, nullptr};
        pg8::gemm_phase<pg8::EpiResid<1>, StaticOrder, true, true>(F.lds + RING_OFF, g, S, E);
        SEAM(10);
    }
    if (IN(11)) { norm_rows<2>(F); }
#undef IN
#undef SEAM
}

extern "C" void kernel_launch(void* const* d_in, const int* in_sizes, int n_in, void* d_out, int out_size, void* d_ws, size_t ws_size, hipStream_t stream) {
    static int grid = 0;
    if (grid == 0) {
        if (n_in != 22 || in_sizes[0] != M * D || out_size != M * D || ws_size < WS_END) { fprintf(stderr, "kernel_launch: unexpected shapes (n_in %d, in0 %d, out %d, ws %zu); nothing launched\n", n_in, n_in > 0 ? in_sizes[0] : -1, out_size, ws_size); grid = -1; return; }
        int dev = 0, cus = 0, per_cu = 0;
        if (hipGetDevice(&dev) != hipSuccess || hipDeviceGetAttribute(&cus, hipDeviceAttributeMultiprocessorCount, dev) != hipSuccess) { fprintf(stderr, "kernel_launch: device query failed\n"); grid = -1; return; }
        if (hipFuncSetAttribute((const void*)mk_fwd, hipFuncAttributeMaxDynamicSharedMemorySize, LDS_BYTES) != hipSuccess) { fprintf(stderr, "kernel_launch: hipFuncSetAttribute failed\n"); grid = -1; return; }
        if (hipOccupancyMaxActiveBlocksPerMultiprocessor(&per_cu, (const void*)mk_fwd, NWAVES * 64, LDS_BYTES) != hipSuccess || per_cu < 1) { fprintf(stderr, "kernel_launch: occupancy query reports %d workgroups per CU\n", per_cu); (void)hipGetLastError(); grid = -1; return; }
        grid = cus;
    }
    if (grid < 0) return;
    if (hipMemsetAsync((char*)d_ws + WS_CTL, 0, CTL_ZERO_BYTES, stream) != hipSuccess) { fprintf(stderr, "kernel_launch: hipMemsetAsync failed\n"); return; }
    Args a{};
    for (int i = 0; i < 22; ++i) a.in[i] = (const float*)d_in[i];
    a.out = (float*)d_out; a.ws = (unsigned char*)d_ws;
    if (N_LAUNCHES == 1) {
        a.ph_lo = 0; a.ph_hi = N_PHASES;
        void* kargs[] = {&a};
        const hipError_t le = hipLaunchCooperativeKernel((const void*)mk_fwd, dim3(grid), dim3(NWAVES * 64), kargs, LDS_BYTES, stream);
        if (le != hipSuccess) fprintf(stderr, "kernel_launch: cooperative launch failed: %s (grid %d)\n", hipGetErrorName(le), grid);
    } else {
        for (int li = 0; li < N_PHASES; ++li) {
            a.ph_lo = li; a.ph_hi = li + 1;
            hipLaunchKernelGGL(mk_fwd, dim3(grid), dim3(NWAVES * 64), LDS_BYTES, stream, a);
            const hipError_t le = hipPeekAtLastError();
            if (le != hipSuccess) { fprintf(stderr, "kernel_launch: launch %d failed: %s\n", li, hipGetErrorName(le)); break; }
        }
    }
}
```

```cpp
#include <hip/hip_runtime.h>
#include <cstdio>
#include <cstdint>
#define MK_N_LAUNCHES 1
namespace pg8 {
#define PG8_LAS __attribute__((address_space(3)))
typedef unsigned short bf16_t;
typedef short bf16x8 __attribute__((ext_vector_type(8)));
typedef float f32x4 __attribute__((ext_vector_type(4)));
typedef unsigned u32x4 __attribute__((ext_vector_type(4)));
constexpr int BM = 256, BK = 64, HALF = 128, HTB = HALF * BK * 2  , STAGE_BYTES = 8 * HTB, NXCD = 8, WGM = 8;

__host__ __device__ __forceinline__ int lds_byte(int r, int c) { const int st = (r >> 4) * 2 + (c >> 5), rr = r & 15, cc = c & 31, ob = rr * 64 + cc * 2; return st * 1024 + (ob ^ (((ob >> 9) & 1) << 5)); }
__host__ __device__ __forceinline__ void stage_rc(int b, int& R, int& C) { const int st = b / 1024, sb = b % 1024, swz = sb ^ (((sb >> 9) & 1) << 5); R = (st >> 1) * 16 + swz / 64; C = (st & 1) * 32 + (swz % 64) / 2; }
__host__ __device__ __forceinline__ int perm32(int rho) { const int n = rho >> 4, i = rho & 15; return 8 * (i >> 2) + 4 * n + (i & 3); }

struct Unit { int pm, pn; };
struct Gemm { const bf16_t* A; const bf16_t* Bt; int M, N, K; };

struct StaticOrder {
    int nM, nN, nwg, G, c;
    __host__ __device__ void init(int M, int N, int G_, int c_) { nM = M / BM; nN = N / BM; nwg = nM * nN; G = G_; c = c_; }
    __host__ __device__ bool next(int i, Unit& u) const {
        const long L = (long)i * G + c; if (L >= nwg) return false;
        int wgid = (int)L; { const int q = nwg / NXCD, r = nwg % NXCD, xcd = wgid % NXCD, off = wgid / NXCD; wgid = (xcd < r ? xcd * (q + 1) : r * (q + 1) + (xcd - r) * q) + off; }
        const int nig = WGM * nN, gid = wgid / nig, fm = gid * WGM, gsz = (nM - fm) < WGM ? (nM - fm) : WGM;
        u.pm = fm + ((wgid % nig) % gsz); u.pn = (wgid % nig) / gsz; return true;
    }
    __device__ __forceinline__ void a_ready(const Unit&) const {}
    __device__ __forceinline__ void done(const Unit&) const {}
};

__device__ __forceinline__ unsigned cvt_pk_bf16(float lo, float hi) { unsigned r; asm volatile("v_cvt_pk_bf16_f32 %0, %1, %2" : "=v"(r) : "v"(lo), "v"(hi)); return r; }
__device__ __forceinline__ float bf_lo(unsigned w) { return __uint_as_float(w << 16); }
__device__ __forceinline__ float bf_hi(unsigned w) { return __uint_as_float(w & 0xffff0000u); }
__device__ __forceinline__ float sigm(float x) { return __builtin_amdgcn_rcpf(1.0f + __expf(-x)); }
__device__ __forceinline__ float gelu_tanh(float x) { const float z = 1.5957691216f * (x + 0.044715f * x * x * x); return x * sigm(z); }
__device__ __forceinline__ u32x4 pack8(const f32x4 v0, const f32x4 v1) { u32x4 w; w.x = cvt_pk_bf16(v0[0], v0[1]); w.y = cvt_pk_bf16(v0[2], v0[3]); w.z = cvt_pk_bf16(v1[0], v1[1]); w.w = cvt_pk_bf16(v1[2], v1[3]); return w; }

struct EpiInMain {
    static constexpr bool PERM = true, AFTER_DRAIN = false;
    bf16_t* UX; bf16_t* UY; bf16_t* UG;
    __device__ __forceinline__ void operator()(const f32x4 (&acc)[2][2][4][2], const Unit& u, int wr, int wc, int fr, int fq) const {
        const int row0 = u.pm * BM + wr * 64 + fr; const int ct = u.pn * BM;
        bf16_t* base; int ldc, colt, act;
        if (ct < 1024) { base = UX; ldc = 1024; colt = ct; act = 0; }
        else if (ct < 2048) { base = UY; ldc = 1024; colt = ct - 1024; act = 1; }
        else { base = UG; ldc = 2048; colt = ct - 2048; act = 2; }
        const int col0 = colt + wc * 32 + 8 * fq;
#pragma unroll
        for (int ai = 0; ai < 2; ++ai)
#pragma unroll
            for (int m = 0; m < 4; ++m) { bf16_t* rowp = base + (size_t)(row0 + ai * HALF + m * 16) * ldc + col0;
#pragma unroll
                for (int bj = 0; bj < 2; ++bj) { f32x4 v0 = acc[ai][bj][m][0], v1 = acc[ai][bj][m][1];
                    if (act == 1) {
#pragma unroll
                        for (int j = 0; j < 4; ++j) { v0[j] = gelu_tanh(v0[j]); v1[j] = gelu_tanh(v1[j]); } }
                    if (act == 2) {
#pragma unroll
                        for (int j = 0; j < 4; ++j) { v0[j] = sigm(v0[j]); v1[j] = sigm(v1[j]); } }
                    *(u32x4*)(rowp + bj * HALF) = pack8(v0, v1); } }
    }
};
template <int ACT  > struct EpiBf16 {
    static constexpr bool PERM = true, AFTER_DRAIN = false;
    bf16_t* O; int ldc;
    __device__ __forceinline__ void operator()(const f32x4 (&acc)[2][2][4][2], const Unit& u, int wr, int wc, int fr, int fq) const {
        const int row0 = u.pm * BM + wr * 64 + fr; const int col0 = u.pn * BM + wc * 32 + 8 * fq;
#pragma unroll
        for (int ai = 0; ai < 2; ++ai)
#pragma unroll
            for (int m = 0; m < 4; ++m) { bf16_t* rowp = O + (size_t)(row0 + ai * HALF + m * 16) * ldc + col0;
#pragma unroll
                for (int bj = 0; bj < 2; ++bj) { f32x4 v0 = acc[ai][bj][m][0], v1 = acc[ai][bj][m][1];
                    if (ACT == 1) {
#pragma unroll
                        for (int j = 0; j < 4; ++j) { const float a = fmaxf(v0[j], 0.f), b = fmaxf(v1[j], 0.f); v0[j] = a * a; v1[j] = b * b; } }
                    *(u32x4*)(rowp + bj * HALF) = pack8(v0, v1); } }
    }
};
struct EpiPQT {
    static constexpr bool PERM = true, AFTER_DRAIN = false;
    bf16_t* PQT;
    __device__ __forceinline__ void operator()(const f32x4 (&acc)[2][2][4][2], const Unit& u, int wr, int wc, int fr, int fq) const {
        const int row0 = u.pm * BM + wr * 64 + fr; const int col0 = u.pn * BM + wc * 32 + 8 * fq;
#pragma unroll
        for (int ai = 0; ai < 2; ++ai)
#pragma unroll
            for (int m = 0; m < 4; ++m) { const int row = row0 + ai * HALF + m * 16; const int pq = row >> 9, j = row & 511;
#pragma unroll
                for (int bj = 0; bj < 2; ++bj) { const int col = col0 + bj * HALF; const int b = col >> 11, t = col & 2047;
                    bf16_t* p = PQT + (((size_t)(b * 512 + j) * 2 + pq) * 2048 + t);
                    *(u32x4*)p = pack8(acc[ai][bj][m][0], acc[ai][bj][m][1]); } }
    }
};
struct EpiDft {
    static constexpr bool PERM = true, AFTER_DRAIN = false;
    bf16_t* YF;
    __device__ __forceinline__ void operator()(const f32x4 (&acc)[2][2][4][2], const Unit& u, int wr, int wc, int fr, int fq) const {
        const int row0 = u.pm * BM + wr * 64 + fr; const int col0 = u.pn * BM + wc * 32 + 8 * fq;
#pragma unroll
        for (int ai = 0; ai < 2; ++ai)
#pragma unroll
            for (int m = 0; m < 4; ++m) { const int k = row0 + ai * HALF + m * 16;
#pragma unroll
                for (int bj = 0; bj < 2; ++bj) { const int col = col0 + bj * HALF; const int b = col >> 9, j = col & 511;
                    bf16_t* p = YF + ((size_t)(b * 2048 + k) * 512 + j);
                    *(u32x4*)p = pack8(acc[ai][bj][m][0], acc[ai][bj][m][1]); } }
    }
};
template <bool HAS_ADD> struct EpiGate {
    static constexpr bool PERM = true, AFTER_DRAIN = false;
    bf16_t* O; int ldc; const bf16_t* G; int ldg; const bf16_t* ADD;
    __device__ __forceinline__ void operator()(const f32x4 (&acc)[2][2][4][2], const Unit& u, int wr, int wc, int fr, int fq) const {
        const int row0 = u.pm * BM + wr * 64 + fr; const int col0 = u.pn * BM + wc * 32 + 8 * fq;
#pragma unroll
        for (int ai = 0; ai < 2; ++ai)
#pragma unroll
            for (int m = 0; m < 4; ++m) { const size_t row = (size_t)(row0 + ai * HALF + m * 16);
#pragma unroll
                for (int bj = 0; bj < 2; ++bj) { const int col = col0 + bj * HALF;
                    const u32x4 g = *(const u32x4*)(G + row * ldg + col);
                    f32x4 v0 = acc[ai][bj][m][0], v1 = acc[ai][bj][m][1];
                    v0[0] *= bf_lo(g.x); v0[1] *= bf_hi(g.x); v0[2] *= bf_lo(g.y); v0[3] *= bf_hi(g.y);
                    v1[0] *= bf_lo(g.z); v1[1] *= bf_hi(g.z); v1[2] *= bf_lo(g.w); v1[3] *= bf_hi(g.w);
                    if (HAS_ADD) { const u32x4 a = *(const u32x4*)(ADD + row * ldc + col);
                        v0[0] += bf_lo(a.x); v0[1] += bf_hi(a.x); v0[2] += bf_lo(a.y); v0[3] += bf_hi(a.y);
                        v1[0] += bf_lo(a.z); v1[1] += bf_hi(a.z); v1[2] += bf_lo(a.w); v1[3] += bf_hi(a.w); }
                    *(u32x4*)(O + row * ldc + col) = pack8(v0, v1); } }
    }
};
template <int MODE> struct EpiResid {
    static constexpr bool PERM = false, AFTER_DRAIN = false;
    const float* X; float* O; const float* gate  ; const float* pos  ;
    __device__ __forceinline__ void operator()(const f32x4 (&acc)[2][2][4][2], const Unit& u, int wr, int wc, int fr, int fq) const {
        const int row0 = u.pm * BM + wr * 64 + fr, col0 = u.pn * BM + wc * 32 + 4 * fq;
#pragma unroll
        for (int ai = 0; ai < 2; ++ai)
#pragma unroll
            for (int m = 0; m < 4; ++m) { const int row = row0 + ai * HALF + m * 16; const int b = row >> 11, t = row & 2047;
#pragma unroll
                for (int bj = 0; bj < 2; ++bj)
#pragma unroll
                    for (int n = 0; n < 2; ++n) { const int c = col0 + bj * HALF + n * 16;
                        const f32x4 gt = *(const f32x4*)(gate + (size_t)b * 6144 + c);
                        f32x4 base;
                        if (MODE == 0) { const f32x4 pv = (c < 512) ? *(const f32x4*)(pos + (t >> 6) * 512 + c) : *(const f32x4*)(pos + 32 * 512 + (t & 63) * 512 + (c - 512));
                            base = *(const f32x4*)(X + (size_t)row * 1024 + c) + pv; }
                        else base = *(const f32x4*)(O + (size_t)row * 1024 + c);
                        *(f32x4*)(O + (size_t)row * 1024 + c) = base + gt * acc[ai][bj][m][n]; }
                asm volatile("" ::: "memory"); }
    }
};

template <class Epi, class Sched, bool ALIGN_EPI = false, bool SP2 = false>
__device__ __forceinline__ void gemm_phase(PG8_LAS unsigned char* lds, const Gemm g, const Sched& S, const Epi& E) {
    const int tid = threadIdx.x, wid = __builtin_amdgcn_readfirstlane(tid >> 6), lane = tid & 63, wr = wid >> 2, wc = wid & 3, fr = lane & 15, fq = lane >> 4;
    const int K = g.K, nt = K / BK;
    unsigned voffA[2], voffB[2];
#pragma unroll
    for (int i = 0; i < 2; ++i) { int R, C; stage_rc(tid * 16 + i * 8192, R, C); const int Rb = Epi::PERM ? ((R & ~31) + perm32(R & 31)) : R;
        voffA[i] = (unsigned)(R * K + C) * 2u; voffB[i] = (unsigned)(Rb * K + C) * 2u; }
    const size_t kstep = (size_t)(BK * 2);
    const size_t hstep = (size_t)HALF * K * 2;
    const size_t tstep = 2 * hstep;
    const unsigned ldsw = (unsigned)wid * 1024u;
    const int aoff = lds_byte(wr * 64 + fr, fq * 8), boff = lds_byte(wc * 32 + fr, fq * 8);
#define PG8_SA(b, h) (((b) * 2 + (h)) * HTB)
#define PG8_SB(b, h) ((4 + (b) * 2 + (h)) * HTB)
#define PG8_STAGE(bufoff, gbase, voff) do { _Pragma("unroll") for (int _i = 0; _i < 2; ++_i) \
        __builtin_amdgcn_global_load_lds((const unsigned*)((const char*)(gbase) + (voff)[_i]), (PG8_LAS unsigned*)(lds + (bufoff) + ldsw + _i * 8192), 16, 0, 0); } while (0)
#define PG8_LDA(dst, b, h) do { _Pragma("unroll") for (int m = 0; m < 4; ++m) _Pragma("unroll") for (int k = 0; k < 2; ++k) dst[m][k] = *(const PG8_LAS bf16x8*)(lds + PG8_SA(b, h) + aoff + m * 2048 + k * 1024); } while (0)
#define PG8_LDB(dst, b, h) do { _Pragma("unroll") for (int n = 0; n < 2; ++n) _Pragma("unroll") for (int k = 0; k < 2; ++k) dst[n][k] = *(const PG8_LAS bf16x8*)(lds + PG8_SB(b, h) + boff + n * 2048 + k * 1024); } while (0)
#define PG8_MMA(ai, bj, At, Bt) do { __builtin_amdgcn_s_setprio(1); _Pragma("unroll") for (int m = 0; m < 4; ++m) _Pragma("unroll") for (int n = 0; n < 2; ++n) _Pragma("unroll") for (int k = 0; k < 2; ++k) \
        acc[ai][bj][m][n] = __builtin_amdgcn_mfma_f32_16x16x32_bf16(Bt[n][k], At[m][k], acc[ai][bj][m][n], 0, 0, 0); __builtin_amdgcn_s_setprio(0); } while (0)
#define PG8_WAIT_V(n) asm volatile("s_waitcnt vmcnt(" #n ")" ::: "memory")
#define PG8_WAIT_L(n) asm volatile("s_waitcnt lgkmcnt(" #n ")" ::: "memory")
#define PG8_BAR __builtin_amdgcn_s_barrier()
#define PG8_SCHED __builtin_amdgcn_sched_barrier(0)
    Unit cur, nxt; int ui = 0;
    if (!S.next(0, cur)) return;
    f32x4 acc[2][2][4][2];
#pragma unroll
    for (int a = 0; a < 2; ++a)
#pragma unroll
        for (int b = 0; b < 2; ++b)
#pragma unroll
            for (int m = 0; m < 4; ++m)
#pragma unroll
                for (int n = 0; n < 2; ++n) acc[a][b][m][n] = (f32x4){0.f, 0.f, 0.f, 0.f};
    bf16x8 At[4][2], B0[2][2], B1[2][2];
    const char* cA = (const char*)g.A + (size_t)cur.pm * tstep; const char* cB = (const char*)g.Bt + (size_t)cur.pn * tstep;
    S.a_ready(cur);
    if constexpr (SP2) {
        PG8_STAGE(PG8_SB(0, 0), cB, voffB); PG8_STAGE(PG8_SB(0, 1), cB + hstep, voffB); PG8_STAGE(PG8_SA(0, 0), cA, voffA); PG8_STAGE(PG8_SA(0, 1), cA + hstep, voffA);
        if (wr == 1) PG8_BAR;
        PG8_WAIT_V(2); PG8_BAR;
        PG8_STAGE(PG8_SB(1, 0), cB + kstep, voffB); PG8_STAGE(PG8_SA(1, 0), cA + kstep, voffA); PG8_STAGE(PG8_SB(1, 1), cB + hstep + kstep, voffB);
        PG8_WAIT_V(6); PG8_BAR;
    } else {
        PG8_STAGE(PG8_SB(0, 0), cB, voffB); PG8_STAGE(PG8_SA(0, 0), cA, voffA); PG8_STAGE(PG8_SB(0, 1), cB + hstep, voffB); PG8_STAGE(PG8_SA(0, 1), cA + hstep, voffA);
        if (wr == 1) PG8_BAR;
        PG8_WAIT_V(4); PG8_BAR;
        PG8_STAGE(PG8_SB(1, 0), cB + kstep, voffB); PG8_STAGE(PG8_SA(1, 0), cA + kstep, voffA); PG8_STAGE(PG8_SB(1, 1), cB + hstep + kstep, voffB);
        PG8_WAIT_V(6); PG8_BAR;
    }
    for (;;) {
        const bool has_next = S.next(ui + 1, nxt);
        const char* nA = has_next ? (const char*)g.A + (size_t)nxt.pm * tstep : cA; const char* nB = has_next ? (const char*)g.Bt + (size_t)nxt.pn * tstep : cB;
        for (int t = 0; t < nt; t += 2) {
            const bool last = (t == nt - 2);
            const char* a1 = cA + (size_t)(t + 1) * kstep;
            const char* a2 = last ? nA : cA + (size_t)(t + 2) * kstep; const char* b2 = last ? nB : cB + (size_t)(t + 2) * kstep;
            const char* a3 = a2 + kstep; const char* b3 = b2 + kstep;
            if (last && has_next) S.a_ready(nxt);
            if constexpr (SP2) {
            PG8_LDB(B0, 0, 0); PG8_LDB(B1, 0, 1); PG8_SCHED; PG8_LDA(At, 0, 0); PG8_STAGE(PG8_SA(1, 1), a1 + hstep, voffA);
            PG8_WAIT_V(8); PG8_WAIT_L(0); PG8_BAR; PG8_MMA(0, 0, At, B0); PG8_MMA(0, 1, At, B1); PG8_BAR; PG8_SCHED;
            PG8_LDA(At, 0, 1); PG8_STAGE(PG8_SB(0, 0), b2, voffB); PG8_STAGE(PG8_SB(0, 1), b2 + hstep, voffB); PG8_STAGE(PG8_SA(0, 0), a2, voffA);
            PG8_WAIT_V(8); PG8_WAIT_L(0); PG8_BAR; PG8_MMA(1, 0, At, B0); PG8_MMA(1, 1, At, B1); PG8_BAR; PG8_SCHED;
            PG8_LDB(B0, 1, 0); PG8_LDB(B1, 1, 1); PG8_SCHED; PG8_LDA(At, 1, 0); PG8_STAGE(PG8_SA(0, 1), a2 + hstep, voffA);
            PG8_WAIT_V(8); PG8_WAIT_L(0); PG8_BAR; PG8_MMA(0, 0, At, B0); PG8_MMA(0, 1, At, B1); PG8_BAR; PG8_SCHED;
            PG8_LDA(At, 1, 1); PG8_STAGE(PG8_SB(1, 0), b3, voffB); PG8_STAGE(PG8_SB(1, 1), b3 + hstep, voffB); PG8_STAGE(PG8_SA(1, 0), a3, voffA);
            PG8_WAIT_V(8); PG8_WAIT_L(0); PG8_BAR; PG8_MMA(1, 0, At, B0); PG8_MMA(1, 1, At, B1); PG8_BAR; PG8_SCHED;
            } else {
            PG8_LDB(B0, 0, 0); PG8_SCHED; PG8_LDA(At, 0, 0); PG8_STAGE(PG8_SA(1, 1), a1 + hstep, voffA);
            PG8_WAIT_L(8); PG8_BAR; PG8_WAIT_L(0); PG8_MMA(0, 0, At, B0); PG8_BAR; PG8_SCHED;
            PG8_LDB(B1, 0, 1); PG8_STAGE(PG8_SB(0, 0), b2, voffB);
            PG8_BAR; PG8_WAIT_L(0); PG8_MMA(0, 1, At, B1); PG8_BAR;
            PG8_LDA(At, 0, 1); PG8_STAGE(PG8_SA(0, 0), a2, voffA);
            PG8_BAR; PG8_WAIT_L(0); PG8_MMA(1, 0, At, B0); PG8_BAR; PG8_SCHED;
            PG8_STAGE(PG8_SB(0, 1), b2 + hstep, voffB);
            PG8_WAIT_V(6); PG8_BAR; PG8_MMA(1, 1, At, B1); PG8_BAR;
            PG8_LDB(B0, 1, 0); PG8_SCHED; PG8_LDA(At, 1, 0); PG8_STAGE(PG8_SA(0, 1), a2 + hstep, voffA);
            PG8_WAIT_L(8); PG8_BAR; PG8_WAIT_L(0); PG8_MMA(0, 0, At, B0); PG8_BAR; PG8_SCHED;
            PG8_LDB(B1, 1, 1); PG8_STAGE(PG8_SB(1, 0), b3, voffB);
            PG8_BAR; PG8_WAIT_L(0); PG8_MMA(0, 1, At, B1); PG8_BAR;
            PG8_LDA(At, 1, 1); PG8_STAGE(PG8_SA(1, 0), a3, voffA);
            PG8_BAR; PG8_WAIT_L(0); PG8_MMA(1, 0, At, B0); PG8_BAR; PG8_SCHED;
            PG8_STAGE(PG8_SB(1, 1), b3 + hstep, voffB);
            PG8_WAIT_V(6); PG8_BAR; PG8_MMA(1, 1, At, B1); PG8_BAR;
            }
        }
        if constexpr (ALIGN_EPI) { if (wr == 0) PG8_BAR; }
        if constexpr (!Epi::AFTER_DRAIN) { E(acc, cur, wr, wc, fr, fq); S.done(cur); }
        if (!has_next) break;
#pragma unroll
        for (int a = 0; a < 2; ++a)
#pragma unroll
            for (int b = 0; b < 2; ++b)
#pragma unroll
                for (int m = 0; m < 4; ++m)
#pragma unroll
                    for (int n = 0; n < 2; ++n) acc[a][b][m][n] = (f32x4){0.f, 0.f, 0.f, 0.f};
        cur = nxt; cA = nA; cB = nB; ++ui;
        if constexpr (ALIGN_EPI) { if (wr == 1) PG8_BAR; }
    }
    PG8_WAIT_V(0);
    if constexpr (!ALIGN_EPI) { if (wr == 0) PG8_BAR; }
    PG8_BAR;
    if constexpr (Epi::AFTER_DRAIN) { E.fused(acc, cur, wr, wc, fr, fq, lds, wid, lane); S.done(cur); }
#undef PG8_SA
#undef PG8_SB
#undef PG8_STAGE
#undef PG8_LDA
#undef PG8_LDB
#undef PG8_MMA
#undef PG8_WAIT_V
#undef PG8_WAIT_L
#undef PG8_BAR
#undef PG8_SCHED
}
}
#define PG8_SP2 true

constexpr int NWAVES = 8;
#ifndef MK_N_LAUNCHES
#define MK_N_LAUNCHES 1
#endif
constexpr int N_PHASES = 13;
constexpr int N_LAUNCHES = MK_N_LAUNCHES;

constexpr int NB = 8, T = 2048, D = 1024, M = NB * T, CT = 256, MC = NB * CT, FW = 512, FF = 4096, NMOD = 6 * D;
constexpr float EPS = 1e-6f;

constexpr size_t MiB = 1u << 20;
constexpr size_t WS_CTL = 0, CTL_ZERO_BYTES = 64 * 1024;
constexpr size_t WS_MODF = 1 * MiB;
constexpr size_t WS_POS = 1 * MiB + 256 * 1024;
constexpr size_t WS_WIN = 2 * MiB;
constexpr size_t WS_W1 = 12 * MiB, WS_W2 = 20 * MiB, WS_WOUT = 28 * MiB, WS_WL = 30 * MiB, WS_WF = 32 * MiB, WS_WG = 33 * MiB;
constexpr size_t WS_HCTX = 34 * MiB, WS_UXC = 38 * MiB;
constexpr size_t WS_HLAT = 48 * MiB;
constexpr size_t WS_UX = 80 * MiB;
constexpr size_t WS_PQT = 112 * MiB;
constexpr size_t WS_YF = 144 * MiB;
constexpr size_t WS_DFTM = 160 * MiB;
constexpr size_t WS_HID = 48 * MiB;
constexpr size_t WS_UY = 176 * MiB;
constexpr size_t WS_YB = 208 * MiB;
constexpr size_t WS_END = 240 * MiB;
constexpr int CW_BAR = 1024;

constexpr int RING_OFF = 0, RING_BYTES = 131072;
constexpr int LDSCTL_OFF = RING_BYTES, MISC_OFF = LDSCTL_OFF + 320;
constexpr int LDS_BYTES = 147456;
static_assert(MISC_OFF + 128 <= LDS_BYTES, "LDS map");

#define GAS __attribute__((address_space(1)))
#define LAS __attribute__((address_space(3)))
typedef unsigned short bf16;
typedef unsigned v4u __attribute__((ext_vector_type(4)));
typedef unsigned v2u __attribute__((ext_vector_type(2)));
typedef float f32x4 __attribute__((ext_vector_type(4)));
typedef float f32x16 __attribute__((ext_vector_type(16)));
typedef short bf16x8 __attribute__((ext_vector_type(8)));
typedef GAS unsigned gu32;
#define RLX_AGENT __ATOMIC_RELAXED, __HIP_MEMORY_SCOPE_AGENT
#define LDS_WAIT() asm volatile("s_waitcnt lgkmcnt(0)" ::: "memory")
#define VM_WAIT() asm volatile("s_waitcnt vmcnt(0)" ::: "memory")
#define CBAR() asm volatile("" ::: "memory")
__device__ __forceinline__ unsigned f2bf(float f) { unsigned u = __builtin_bit_cast(unsigned, f); return (u + 0x7fffu + ((u >> 16) & 1u)) >> 16; }
__device__ __forceinline__ unsigned pk2(float lo, float hi) { return f2bf(lo) | (f2bf(hi) << 16); }
__device__ __forceinline__ float bflo(unsigned w) { return __uint_as_float(w << 16); }
__device__ __forceinline__ float bfhi(unsigned w) { return __uint_as_float(w & 0xffff0000u); }
__device__ __forceinline__ float bf1(unsigned short h) { return __uint_as_float(((unsigned)h) << 16); }

#define XB_TMO      128
#define XB_XCNT(j)  (256  + 64 * (j))
#define XB_XSUB(j)  (1280 + 64 * (j))
#define XB_XGEN(j)  (2304 + 64 * (j))
#define XB_TOP      3328
#define XB_TOPGEN   3392
#define XCD_BAR_WORDS 3456
#define XB_SPIN_CAP (1u << 18)

__device__ __forceinline__ unsigned xb_ld(unsigned* p)              { return __hip_atomic_load(p, __ATOMIC_RELAXED, __HIP_MEMORY_SCOPE_AGENT); }
__device__ __forceinline__ unsigned xb_add(unsigned* p, unsigned v) { return __hip_atomic_fetch_add(p, v, __ATOMIC_RELAXED, __HIP_MEMORY_SCOPE_AGENT); }
__device__ __forceinline__ unsigned xb_xcc_id() { return (unsigned)__builtin_amdgcn_s_getreg((3 << 11) | 20) & 0xFu; }
#define XB_SPIN(cond, bar) do { unsigned _sp = 0; while (cond) { __builtin_amdgcn_s_sleep(1); \
    if ((++_sp & 255u) == 0u) { if (xb_ld(&(bar)[XB_TMO])) break; if (_sp > XB_SPIN_CAP) { atomicAdd(&(bar)[XB_TMO], 1u); break; } } } } while (0)

struct XcdBarrier {
    unsigned* bar; unsigned x;
    volatile LAS unsigned* st;
};

__device__ __forceinline__ XcdBarrier xcd_barrier_post(unsigned* bar, volatile LAS unsigned* st) {
    XcdBarrier b; b.bar = bar; b.x = xb_xcc_id(); b.st = st;
    if (threadIdx.x == 0) (void)xb_add(&bar[XB_XCNT(b.x)], 1u);
    return b;
}
__device__ __forceinline__ void xcd_barrier_complete(unsigned* bar, unsigned x, unsigned& nloc, unsigned& nx) {
    const unsigned G = gridDim.x * gridDim.y * gridDim.z;
    unsigned sum, cnt, mine, sp = 0u;
    for (;;) {
        sum = 0u; cnt = 0u; mine = 0u;
#pragma unroll
        for (unsigned j = 0; j < 16; ++j) { const unsigned c = xb_ld(&bar[XB_XCNT(j)]); sum += c; cnt += (c > 0u) ? 1u : 0u; mine = (j == x) ? c : mine; }
        if (sum == G) break;
        __builtin_amdgcn_s_sleep(1);
        if ((++sp & 255u) == 0u) { if (xb_ld(&bar[XB_TMO])) break; if (sp > XB_SPIN_CAP) { atomicAdd(&bar[XB_TMO], 1u); break; } }
    }
    nloc = mine > 0u ? mine : 1u; nx = cnt > 0u ? cnt : 1u;
}

__device__ __forceinline__ void xcd_barrier(const XcdBarrier& b) {
    asm volatile("s_waitcnt vmcnt(0)" ::: "memory");
    __syncthreads();
    if (threadIdx.x == 0) {
        unsigned* bar = b.bar;
        __builtin_amdgcn_s_waitcnt(0);
        unsigned nloc = b.st[0], nx = b.st[1];
        if (nloc == 0u) { xcd_barrier_complete(bar, b.x, nloc, nx); b.st[0] = nloc; b.st[1] = nx; }
        const unsigned old = xb_add(&bar[XB_XSUB(b.x)], 1u);
        const unsigned gen = old / nloc;
        if (old + 1u == (gen + 1u) * nloc) {
            __builtin_amdgcn_fence(__ATOMIC_RELEASE, "agent");
            asm volatile("s_waitcnt vmcnt(0)" ::: "memory");
            const unsigned og = xb_add(&bar[XB_TOP], 1u);
            const unsigned tg = og / nx;
            if (og + 1u == (tg + 1u) * nx) xb_add(&bar[XB_TOPGEN], 1u);
            else XB_SPIN(xb_ld(&bar[XB_TOPGEN]) == tg, bar);
            __builtin_amdgcn_fence(__ATOMIC_ACQUIRE, "agent");
            xb_add(&bar[XB_XGEN(b.x)], 1u);
            asm volatile("s_waitcnt vmcnt(0)" ::: "memory");
        } else {
            XB_SPIN(xb_ld(&bar[XB_XGEN(b.x)]) == gen, bar);
            __builtin_amdgcn_fence(__ATOMIC_ACQUIRE, "agent");
            asm volatile("s_waitcnt vmcnt(0)" ::: "memory");
        }
    }
    __syncthreads();
}

struct Frame {
    LAS unsigned char* lds;
    volatile LAS unsigned* MISC;
    gu32* ctl;
    int tid, lane, wave;
    int vcu, G;
    const float *x, *c, *ctx, *c_ctx, *w_mod, *b_mod, *g_mix, *w_in, *conv_w, *conv_b, *w_a, *b_a, *w_x, *b_x, *lam, *w_lru_out, *w_f_out, *w_out, *g_mlp, *w1, *w2, *g_final;
    float* out;
    float *MODF, *POS;
    bf16 *WIN, *W1T, *W2T, *WOUT, *WL, *WF, *WG, *HCTX, *UXC, *HLAT, *UX, *PQT, *YF, *DFTM, *HID, *UY, *YB, *UG, *XC, *XCC;
};

__device__ __forceinline__ float wave_sum(float v) {
#pragma unroll
    for (int o = 1; o < 64; o <<= 1) v += __shfl_xor(v, o);
    return v;
}
__device__ __forceinline__ float sigm(float x) { return __builtin_amdgcn_rcpf(1.0f + __expf(-x)); }

__device__ __forceinline__ void p0_transpose_item(const float* W, int K, int ldw, int col0, int nblk, bf16* WT, int row_off, LAS float* scr, int item, int lane) {
    const int kb = item / nblk, nb = item % nblk, k0 = 64 * kb, n0 = 32 * nb;
#pragma unroll 8
    for (int i = 0; i < 32; ++i) { const int kk = 2 * i + (lane >> 5); scr[kk * 33 + (lane & 31)] = W[(size_t)(k0 + kk) * ldw + col0 + n0 + (lane & 31)]; }
    LDS_WAIT(); CBAR();
    const int c = lane & 7;
#pragma unroll
    for (int j = 0; j < 4; ++j) { const int n = (lane >> 3) + 8 * j; const LAS float* s = scr + (8 * c) * 33 + n;
        v4u o; o.x = pk2(s[0 * 33], s[1 * 33]); o.y = pk2(s[2 * 33], s[3 * 33]); o.z = pk2(s[4 * 33], s[5 * 33]); o.w = pk2(s[6 * 33], s[7 * 33]);
        *(v4u*)(WT + (size_t)(row_off + n0 + n) * K + k0 + 8 * c) = o; }
    LDS_WAIT(); CBAR();
}

__device__ __forceinline__ void p0_prologue(Frame& F) {
    LAS float* sc = (LAS float*)(F.lds);
    LAS float* red = (LAS float*)(F.lds + 36864);
    LAS float* trig = (LAS float*)(F.lds + 49152);
    for (int idx = F.tid; idx < 9 * 1024; idx += NWAVES * 64) { const int r = idx >> 10, k = idx & 1023; const float v = (r < 8) ? F.c[r * 1024 + k] : F.c_ctx[k]; sc[idx] = v * sigm(v); }
    if (F.tid < 128) { float s, c; sincospif((float)F.tid * (1.0f / 64.0f), &s, &c); trig[F.tid] = c; trig[128 + F.tid] = s; }
    __syncthreads();
    for (int item = F.vcu; item < NMOD / 32; item += F.G) {
        const int n0 = item * 32, kh = F.lane >> 5, nl = F.lane & 31;
        float acc[9];
#pragma unroll
        for (int r = 0; r < 9; ++r) acc[r] = 0.f;
#pragma unroll 8
        for (int i = 0; i < 64; ++i) { const int k = F.wave * 128 + 2 * i + kh; const float w = F.w_mod[(size_t)k * NMOD + n0 + nl];
#pragma unroll
            for (int r = 0; r < 9; ++r) acc[r] += sc[r * 1024 + k] * w; }
#pragma unroll
        for (int r = 0; r < 9; ++r) acc[r] += __shfl_xor(acc[r], 32);
        if (F.lane < 32) {
#pragma unroll
            for (int r = 0; r < 9; ++r) red[(F.wave * 9 + r) * 32 + nl] = acc[r]; }
        __syncthreads();
        if (F.tid < 288) { const int r = F.tid >> 5, n = F.tid & 31; float s = F.b_mod[n0 + n];
#pragma unroll
            for (int w = 0; w < 8; ++w) s += red[(w * 9 + r) * 32 + n];
            F.MODF[r * NMOD + n0 + n] = s; }
        __syncthreads();
    }
    LAS float* scr = (LAS float*)(F.lds + 53248 + F.wave * 8704);
    const int gw = F.vcu * NWAVES + F.wave, NGW = F.G * NWAVES;
    constexpr int I_IN1 = 16 * 64, I_IN2 = 16 * 64, I_W1 = 16 * 128, I_W2 = 64 * 32, I_WO = 16 * 32, I_WLR = 16 * 32, I_WF = 8 * 32, I_G = 16 * 8;
    constexpr int I_PQ = 4 * 2 * 8 * 16, I_POS = 96, I_DFT = 2048;
    constexpr int NITEMS = I_IN1 + I_IN2 + I_W1 + I_W2 + I_WO + I_WLR + I_WF + 2 * I_G + I_PQ + I_POS + I_DFT;
    for (int it = gw; it < NITEMS; it += NGW) {
        int r = it;
        if (r < I_IN1) { p0_transpose_item(F.w_in, 1024, 4608, 0, 64, F.WIN, 0, scr, r, F.lane); continue; } r -= I_IN1;
        if (r < I_IN2) { p0_transpose_item(F.w_in, 1024, 4608, 2560, 64, F.WIN, 2048, scr, r, F.lane); continue; } r -= I_IN2;
        if (r < I_W1) { p0_transpose_item(F.w1, 1024, 4096, 0, 128, F.W1T, 0, scr, r, F.lane); continue; } r -= I_W1;
        if (r < I_W2) { p0_transpose_item(F.w2, 4096, 1024, 0, 32, F.W2T, 0, scr, r, F.lane); continue; } r -= I_W2;
        if (r < I_WO) { p0_transpose_item(F.w_out, 1024, 1024, 0, 32, F.WOUT, 0, scr, r, F.lane); continue; } r -= I_WO;
        if (r < I_WLR) { p0_transpose_item(F.w_lru_out, 1024, 1024, 0, 32, F.WL, 0, scr, r, F.lane); continue; } r -= I_WLR;
        if (r < I_WF) { p0_transpose_item(F.w_f_out, 512, 1024, 0, 32, F.WF, 0, scr, r, F.lane); continue; } r -= I_WF;
        if (r < I_G) { const int mat = r >> 3;
            p0_transpose_item(F.w_a + (size_t)mat * 16384, 128, 128, 0, 4, F.WG, mat * 256, scr, r & 7, F.lane); continue; } r -= I_G;
        if (r < I_G) { const int mat = r >> 3;
            p0_transpose_item(F.w_x + (size_t)mat * 16384, 128, 128, 0, 4, F.WG, mat * 256 + 128, scr, r & 7, F.lane); continue; } r -= I_G;
        if (r < I_PQ) {
            const int kc = r & 15, mc = (r >> 4) & 7, pq = (r >> 7) & 1, g = r >> 8;
            const int k = kc * 64 + F.lane, m0 = mc * 16;
            const float* wrow = F.w_in + (size_t)k * 4608 + 2048 + g * 128;
            const LAS float* tg = trig + pq * 128;
            float acc[16];
#pragma unroll
            for (int mm = 0; mm < 16; ++mm) acc[mm] = 0.f;
            for (int c4 = 0; c4 < 32; ++c4) { const f32x4 w4 = *(const f32x4*)(wrow + 4 * c4);
#pragma unroll
                for (int cc = 0; cc < 4; ++cc) { const int c = 4 * c4 + cc;
#pragma unroll
                    for (int mm = 0; mm < 16; ++mm) acc[mm] += tg[((m0 + mm) * c) & 127] * w4[cc]; } }
#pragma unroll
            for (int mm = 0; mm < 16; ++mm) F.WIN[(size_t)(4096 + pq * 512 + g * 128 + m0 + mm) * 1024 + k] = (bf16)f2bf(acc[mm] * (1.0f / 512.0f));
            continue; } r -= I_PQ;
        if (r < I_POS) {
            const float p = (float)(r < 32 ? r : r - 32);
#pragma unroll
            for (int j = 0; j < 8; ++j) { const int ch = j * 64 + F.lane, i = ch & 255;
                const float freq = expf(-9.210340371976184f * (float)i / 256.0f); const float ang = p * freq;
                float s, c; sincospif(ang * 0.3183098861837907f, &s, &c);
                F.POS[r * 512 + ch] = (ch < 256) ? s : c; }
            continue; } r -= I_POS;
        {
            const int k = r;
#pragma unroll 1
            for (int q = 0; q < 8; ++q) { const int col0 = (q * 64 + F.lane) * 8; float v[8];
#pragma unroll
                for (int j = 0; j < 8; ++j) { const int col = col0 + j, t = col & 2047; const int ph = (k * t) & 2047; float s, c; sincospif((float)ph * (1.0f / 1024.0f), &s, &c); v[j] = (col < 2048) ? c : -s; }
                v4u o; o.x = pk2(v[0], v[1]); o.y = pk2(v[2], v[3]); o.z = pk2(v[4], v[5]); o.w = pk2(v[6], v[7]);
                *(v4u*)(F.DFTM + (size_t)k * 4096 + col0) = o; }
        }
    }
}

template <int MODE> __device__ __forceinline__ void norm_rows(Frame& F) {
    const int gw = F.vcu * NWAVES + F.wave, NGW = F.G * NWAVES;
    const int nrows = (MODE == 0) ? (M + MC) : M;
    const float* gvec = (MODE == 0) ? F.g_mix : (MODE == 1 ? F.g_mlp : F.g_final);
    f32x4 g[4];
#pragma unroll
    for (int j = 0; j < 4; ++j) g[j] = *(const f32x4*)(gvec + 256 * j + 4 * F.lane);
    for (int row = gw; row < nrows; row += NGW) {
        const bool lat = row < M;
        const float* src = (MODE == 0) ? (lat ? F.x + (size_t)row * D : F.ctx + (size_t)(row - M) * D) : F.out + (size_t)row * D;
        f32x4 v[4]; float ss = 0.f;
#pragma unroll
        for (int j = 0; j < 4; ++j) v[j] = *(const f32x4*)(src + 256 * j + 4 * F.lane);
        if (MODE == 0 && lat) { const int t = row & (T - 1);
#pragma unroll
            for (int j = 0; j < 4; ++j) { const int c = 256 * j + 4 * F.lane;
                const f32x4 pv = (j < 2) ? *(const f32x4*)(F.POS + (t >> 6) * 512 + c) : *(const f32x4*)(F.POS + 32 * 512 + (t & 63) * 512 + (c - 512));
                v[j] = v[j] + pv; } }
#pragma unroll
        for (int j = 0; j < 4; ++j) ss += (v[j].x * v[j].x + v[j].y * v[j].y) + (v[j].z * v[j].z + v[j].w * v[j].w);
        const float rstd = 1.0f / sqrtf(wave_sum(ss) * (1.0f / D) + EPS);
        if (MODE == 2) {
#pragma unroll
            for (int j = 0; j < 4; ++j) *(f32x4*)(F.out + (size_t)row * D + 256 * j + 4 * F.lane) = v[j] * rstd * g[j];
        } else {
            const int mrow = lat ? (row >> 11) : 8;
            const float* mod = F.MODF + (size_t)mrow * NMOD + (MODE == 0 ? 0 : 3072);
            bf16* dst = (MODE == 0) ? (lat ? F.HLAT + (size_t)row * D : F.HCTX + (size_t)(row - M) * D) : F.UY + (size_t)row * D;
#pragma unroll
            for (int j = 0; j < 4; ++j) { const int c = 256 * j + 4 * F.lane;
                const f32x4 sh = *(const f32x4*)(mod + c), scl = *(const f32x4*)(mod + 1024 + c);
                const f32x4 h = v[j] * rstd * g[j] * (scl + 1.0f) + sh;
                v2u o; o.x = pk2(h.x, h.y); o.y = pk2(h.z, h.w);
                *(v2u*)(dst + c) = o; }
        }
    }
}

__device__ __forceinline__ void conv_phase(Frame& F) {
    const int gw = F.vcu * NWAVES + F.wave, NGW = F.G * NWAVES, lane = F.lane;
    for (int it = gw; it < 4608; it += NGW) {
        const bool lat = it < 4096; const int r = lat ? it : it - 4096;
        const int half = r & 1, row0 = (r >> 1) * 8;
        const int Tseg = lat ? T : CT; const int t0 = row0 & (Tseg - 1);
        const int c0 = half * 512 + lane * 8;
        const bf16* src = (lat ? F.UX : F.UXC) + (size_t)(row0 - t0) * D + c0;
        bf16* dst = (lat ? F.XC : F.XCC) + (size_t)(row0 - t0) * D + c0;
        v4u v[11];
#pragma unroll
        for (int i = 0; i < 11; ++i) { const int tt = t0 - 2 + i; v[i] = (tt >= 0 && tt < Tseg) ? *(const v4u*)(src + (size_t)tt * D) : (v4u){0u, 0u, 0u, 0u}; }
        f32x4 cw[4][2], cb[2];
#pragma unroll
        for (int k = 0; k < 4; ++k) { cw[k][0] = *(const f32x4*)(F.conv_w + k * 1024 + c0); cw[k][1] = *(const f32x4*)(F.conv_w + k * 1024 + c0 + 4); }
        cb[0] = *(const f32x4*)(F.conv_b + c0); cb[1] = *(const f32x4*)(F.conv_b + c0 + 4);
#pragma unroll
        for (int o = 0; o < 8; ++o) { f32x4 x0 = cb[0], x1 = cb[1];
#pragma unroll
            for (int k = 0; k < 4; ++k) { const v4u u = v[o + k];
                x0[0] += cw[k][0][0] * bflo(u.x); x0[1] += cw[k][0][1] * bfhi(u.x); x0[2] += cw[k][0][2] * bflo(u.y); x0[3] += cw[k][0][3] * bfhi(u.y);
                x1[0] += cw[k][1][0] * bflo(u.z); x1[1] += cw[k][1][1] * bfhi(u.z); x1[2] += cw[k][1][2] * bflo(u.w); x1[3] += cw[k][1][3] * bfhi(u.w); }
            *(v4u*)(dst + (size_t)(t0 + o) * D) = pg8::pack8(x0, x1); }
    }
}

constexpr int SC_W = 0;
constexpr int SC_TAB = 2 * 64 * 272;
template <int DIR>
__device__ __forceinline__ void scan_pass(Frame& F, int b, int hd, int q, float& carry, int& round, bf16* ya_dst) {
    const int lane = F.lane, w = F.wave, h = lane >> 5, cl = lane & 31;
    const LAS unsigned char* wl = F.lds + SC_W + DIR * (64 * 272);
    LAS float* tab = (LAS float*)(F.lds + SC_TAB);
    const int ch = hd * 128 + q * 32 + cl;
    constexpr float L2E = 1.4426950408889634f;
    const float cr = -F.b_a[DIR * 1024 + ch] * L2E, ci = -F.b_x[DIR * 1024 + ch] * L2E;
    const float nsp8 = -8.0f * log1pf(expf(-F.lam[DIR * 1024 + ch]));
    const float nsp8l = nsp8 * L2E;
    bf16x8 I0, I1;
#pragma unroll
    for (int j = 0; j < 8; ++j) { I0[j] = (8 * h + j == cl) ? (short)0x3F80 : (short)0; I1[j] = (16 + 8 * h + j == cl) ? (short)0x3F80 : (short)0; }
    const bf16* xlat = F.XC + (size_t)b * T * D + hd * 128 + 8 * h + (size_t)cl * D;
    const bf16* xctx = F.XCC + (size_t)b * CT * D + hd * 128 + 8 * h + (size_t)cl * D;
#define SC_R0(R_) ((R_) == 0 ? 0 : ((DIR == 0) ? ((R_) - 1) : (4 - (R_))) * 512)
#define SC_PTR(R_, mt_) (((R_) == 0 ? xctx : xlat) + (size_t)(SC_R0(R_) + 64 * w + 32 * (mt_)) * D)
#define SC_LOADX(X_, R_, mt_) do { const bf16* p_ = SC_PTR(R_, mt_); _Pragma("unroll") for (int ks_ = 0; ks_ < 8; ++ks_) X_[ks_] = *(const bf16x8*)(p_ + ks_ * 16); } while (0)
    bf16x8 X0[8], X1[8];
    const int firstR = (w < 4) ? 0 : 1;
    SC_LOADX(X0, firstR, 0);
#pragma unroll 1
    for (int R = 0; R < 5; ++R) {
        const int r0 = SC_R0(R);
        const int nact = (R == 0) ? 4 : 8;
        const bool active = w < nact;
        const int t0 = r0 + 64 * w;
        float av[2][16], bv[2][16];
        float preA[8], preH[8];
        bf16x8 Yh[2][2], Yu[2][2];
#define SC_LOADY(mt_) do { _Pragma("unroll") for (int s_ = 0; s_ < 2; ++s_) { const size_t o_ = ((size_t)b * T + t0 + 32 * (mt_) + cl) * D + hd * 128 + q * 32 + 16 * s_ + 8 * h; \
            Yh[mt_][s_] = *(const bf16x8*)(F.HLAT + o_); Yu[mt_][s_] = *(const bf16x8*)(F.UY + o_); } } while (0)
        if (active) {
#pragma unroll
            for (int mt = 0; mt < 2; ++mt) {
                if (mt == 0) SC_LOADX(X1, R, 1); else { const int Rn = (R < 4) ? R + 1 : R; SC_LOADX(X0, Rn, 0); }
                f32x16 accr, acci, accx;
#pragma unroll
                for (int i = 0; i < 16; ++i) { accr[i] = 0.f; acci[i] = 0.f; accx[i] = 0.f; }
#pragma unroll
                for (int ks = 0; ks < 8; ++ks) { const bf16x8 af = (mt == 0) ? X0[ks] : X1[ks];
                    const bf16x8 br = *(const LAS bf16x8*)(wl + cl * 272 + (ks * 16 + 8 * h) * 2);
                    const bf16x8 bi = *(const LAS bf16x8*)(wl + (32 + cl) * 272 + (ks * 16 + 8 * h) * 2);
                    accr = __builtin_amdgcn_mfma_f32_32x32x16_bf16(af, br, accr, 0, 0, 0);
                    acci = __builtin_amdgcn_mfma_f32_32x32x16_bf16(af, bi, acci, 0, 0, 0); }
                __builtin_amdgcn_sched_barrier(0);
                {
                    bf16x8 fa, fb;
                    if (mt == 0) { fa = (q == 0) ? X0[0] : (q == 1) ? X0[2] : (q == 2) ? X0[4] : X0[6]; fb = (q == 0) ? X0[1] : (q == 1) ? X0[3] : (q == 2) ? X0[5] : X0[7]; }
                    else         { fa = (q == 0) ? X1[0] : (q == 1) ? X1[2] : (q == 2) ? X1[4] : X1[6]; fb = (q == 0) ? X1[1] : (q == 1) ? X1[3] : (q == 2) ? X1[5] : X1[7]; }
                    accx = __builtin_amdgcn_mfma_f32_32x32x16_bf16(fa, I0, accx, 0, 0, 0);
                    accx = __builtin_amdgcn_mfma_f32_32x32x16_bf16(fb, I1, accx, 0, 0, 0); }
                __builtin_amdgcn_sched_barrier(0);
#pragma unroll
                for (int reg = 0; reg < 16; ++reg) {
                    const float e1 = __builtin_amdgcn_exp2f(accr[reg] * (-L2E) + cr), e2 = __builtin_amdgcn_exp2f(acci[reg] * (-L2E) + ci);
                    const float rg = __builtin_amdgcn_rcpf(1.0f + e1), ig = __builtin_amdgcn_rcpf(1.0f + e2);
                    const float a = __builtin_amdgcn_exp2f(nsp8l * rg);
                    const float x2 = 2.0f * nsp8 * rg;
                    float pz = x2 * (1.0f / 24.0f) + (1.0f / 6.0f); pz = pz * x2 + 0.5f; pz = pz * x2 + 1.0f;
                    const float m2 = (x2 > -0.3f) ? (-x2 * pz) : (1.0f - a * a);
                    av[mt][reg] = a; bv[mt][reg] = __builtin_amdgcn_sqrtf(m2) * ig * accx[reg]; }
                __builtin_amdgcn_sched_barrier(0);
            }
            __builtin_amdgcn_sched_barrier(0);
            float gA[8], gH[8];
#pragma unroll
            for (int mt = 0; mt < 2; ++mt)
#pragma unroll
                for (int g4 = 0; g4 < 4; ++g4) { float ar = 1.f, hr = 0.f;
#pragma unroll
                    for (int ii = 0; ii < 4; ++ii) { const int i = g4 * 4 + (DIR == 0 ? ii : 3 - ii);
                        hr = av[mt][i] * hr + bv[mt][i]; ar = ar * av[mt][i]; av[mt][i] = ar; bv[mt][i] = hr; }
                    gA[mt * 4 + g4] = ar; gH[mt * 4 + g4] = hr; }
            float pA[8], pH[8];
#pragma unroll
            for (int gi = 0; gi < 8; ++gi) { pA[gi] = __shfl_xor(gA[gi], 32); pH[gi] = __shfl_xor(gH[gi], 32); }
            float Ar = 1.f, Hr = 0.f;
#pragma unroll
            for (int gg = 0; gg < 8; ++gg) { const int gi = (DIR == 0) ? gg : 7 - gg;
                const bool own_first = (DIR == 0) ? (h == 0) : (h == 1);
                const float fA = own_first ? gA[gi] : pA[gi], fH = own_first ? gH[gi] : pH[gi];
                const float sA = own_first ? pA[gi] : gA[gi], sH = own_first ? pH[gi] : gH[gi];
                const float Ar1 = fA * Ar, Hr1 = fA * Hr + fH;
                preA[gi] = own_first ? Ar : Ar1; preH[gi] = own_first ? Hr : Hr1;
                Ar = sA * Ar1; Hr = sA * Hr1 + sH; }
            __builtin_amdgcn_sched_barrier(0);
            if (DIR == 1 && R > 0) SC_LOADY(0);
            if (lane < 32) { tab[((round & 1) * 8 + w) * 64 + cl] = Ar; tab[((round & 1) * 8 + w) * 64 + 32 + cl] = Hr; }
        }
        __syncthreads();
        float my = carry; { float c = carry;
#pragma unroll
            for (int ww = 0; ww < 8; ++ww) { const int w2 = (DIR == 0) ? ww : 7 - ww;
                if (w2 < nact) { if (w2 == w) my = c; c = tab[((round & 1) * 8 + w2) * 64 + cl] * c + tab[((round & 1) * 8 + w2) * 64 + 32 + cl]; } }
            carry = c; }
        ++round;
        if (active && R > 0) {
            if (DIR == 1) SC_LOADY(1);
#pragma unroll
            for (int mt = 0; mt < 2; ++mt) {
                f32x16 hfC, gyC;
                if (DIR == 1) {
#pragma unroll
                    for (int i = 0; i < 16; ++i) { hfC[i] = 0.f; gyC[i] = 0.f; }
                    hfC = __builtin_amdgcn_mfma_f32_32x32x16_bf16(Yh[mt][0], I0, hfC, 0, 0, 0); hfC = __builtin_amdgcn_mfma_f32_32x32x16_bf16(Yh[mt][1], I1, hfC, 0, 0, 0);
                    gyC = __builtin_amdgcn_mfma_f32_32x32x16_bf16(Yu[mt][0], I0, gyC, 0, 0, 0); gyC = __builtin_amdgcn_mfma_f32_32x32x16_bf16(Yu[mt][1], I1, gyC, 0, 0, 0); }
#pragma unroll
                for (int reg = 0; reg < 16; ++reg) { const int gi = mt * 4 + (reg >> 2);
                    const float gc = preH[gi] + preA[gi] * my;
                    const float hv = bv[mt][reg] + av[mt][reg] * gc;
                    const int tok = t0 + 32 * mt + 8 * (reg >> 2) + 4 * h + (reg & 3);
                    const size_t idx = ((size_t)b * T + tok) * D + ch;
                    if (DIR == 0) F.HLAT[idx] = (bf16)(pg8::cvt_pk_bf16(hv, hv) & 0xffffu);
                    else { const float y = (hfC[reg] + hv) * gyC[reg]; ya_dst[idx] = (bf16)(pg8::cvt_pk_bf16(y, y) & 0xffffu); } }
            }
        }
    }
#undef SC_R0
#undef SC_PTR
#undef SC_LOADX
#undef SC_LOADY
}
__device__ __forceinline__ void scan_phase(Frame& F, bf16* ya_dst) {
    int round = 0;
    for (int item = F.vcu; item < NB * 8 * 4; item += F.G) {
        const int q = item & 3, hd = (item >> 2) & 7, b = item >> 5;
        for (int i = F.tid; i < 2048; i += NWAVES * 64) { const int ck = i & 15, row = (i >> 4) & 63, dir = i >> 10; const int g = row >> 5, e = row & 31;
            const v4u v = *(const v4u*)(F.WG + ((size_t)((dir * 8 + hd) * 256 + g * 128 + q * 32 + e)) * 128 + ck * 8);
            *(LAS v4u*)(F.lds + SC_W + dir * (64 * 272) + row * 272 + ck * 16) = v; }
        __syncthreads();
        float carry = 0.f;
        scan_pass<0>(F, b, hd, q, carry, round, ya_dst);
        VM_WAIT(); __syncthreads();
        carry = 0.f;
        scan_pass<1>(F, b, hd, q, carry, round, ya_dst);
        __syncthreads();
    }
}

struct Args { const float* in[22]; float* out; unsigned char* ws; int ph_lo, ph_hi; };
__global__ void __launch_bounds__(NWAVES * 64, 2) mk_fwd(Args args) {
    extern __shared__ __attribute__((aligned(16))) unsigned char lds[];
    Frame F;
    F.lds = (LAS unsigned char*)lds;
    F.MISC = (volatile LAS unsigned*)(F.lds + MISC_OFF);
    F.tid = threadIdx.x; F.lane = F.tid & 63; F.wave = __builtin_amdgcn_readfirstlane(F.tid >> 6);
    F.G = gridDim.x; { const int bx = blockIdx.x; F.vcu = (F.G % 8 == 0) ? (bx % 8) * (F.G / 8) + bx / 8 : bx; }
    unsigned char* ws = args.ws;
    F.ctl = (gu32*)(ws + WS_CTL);
    F.x = args.in[0]; F.c = args.in[1]; F.ctx = args.in[2]; F.c_ctx = args.in[3]; F.w_mod = args.in[4]; F.b_mod = args.in[5]; F.g_mix = args.in[6]; F.w_in = args.in[7];
    F.conv_w = args.in[8]; F.conv_b = args.in[9]; F.w_a = args.in[10]; F.b_a = args.in[11]; F.w_x = args.in[12]; F.b_x = args.in[13]; F.lam = args.in[14];
    F.w_lru_out = args.in[15]; F.w_f_out = args.in[16]; F.w_out = args.in[17]; F.g_mlp = args.in[18]; F.w1 = args.in[19]; F.w2 = args.in[20]; F.g_final = args.in[21];
    F.out = args.out;
    F.MODF = (float*)(ws + WS_MODF); F.POS = (float*)(ws + WS_POS);
    F.WIN = (bf16*)(ws + WS_WIN); F.W1T = (bf16*)(ws + WS_W1); F.W2T = (bf16*)(ws + WS_W2); F.WOUT = (bf16*)(ws + WS_WOUT); F.WL = (bf16*)(ws + WS_WL); F.WF = (bf16*)(ws + WS_WF); F.WG = (bf16*)(ws + WS_WG);
    F.HCTX = (bf16*)(ws + WS_HCTX); F.UXC = (bf16*)(ws + WS_UXC); F.HLAT = (bf16*)(ws + WS_HLAT); F.UX = (bf16*)(ws + WS_UX); F.PQT = (bf16*)(ws + WS_PQT); F.YF = (bf16*)(ws + WS_YF);
    F.DFTM = (bf16*)(ws + WS_DFTM); F.HID = (bf16*)(ws + WS_HID); F.UY = (bf16*)(ws + WS_UY); F.YB = (bf16*)(ws + WS_YB); F.UG = (bf16*)args.out; F.XC = F.YB; F.XCC = F.HCTX;
    for (int u = F.tid; u < (LDS_BYTES - LDSCTL_OFF) / 4; u += NWAVES * 64) ((LAS unsigned*)(F.lds + LDSCTL_OFF))[u] = 0u;
    __syncthreads();
    const bool one_launch = (args.ph_hi - args.ph_lo) > 1;
    XcdBarrier bar; bar.bar = (unsigned*)(F.ctl + CW_BAR); bar.x = 0; bar.st = nullptr;
    if (one_launch) bar = xcd_barrier_post((unsigned*)(F.ctl + CW_BAR), F.MISC + 8);
    const int lo = args.ph_lo, hi = args.ph_hi;
#ifdef ONLY_PH
#define IN(k) ((k) == ONLY_PH)
#else
#define IN(k) (lo <= (k) && (k) < hi)
#endif
#define SEAM(k) do { if (IN(k) && IN((k) + 1)) xcd_barrier(bar); } while (0)
    using pg8::Gemm; using pg8::StaticOrder;
    const int cid = (int)blockIdx.x;

#ifndef REP_PH
#define REP_PH -1
#define REP_N 1
#endif
#define REPS(k) ((k) == REP_PH ? REP_N : 1)
#define REPBAR(k) do { if (rep + 1 < REPS(k)) xcd_barrier(bar); } while (0)
    int ph = 0;
#define PHASE_BEGIN if (IN(ph)) { for (int rep = 0; rep < REPS(ph); ++rep) {
#define PHASE_END   REPBAR(ph); } SEAM(ph); } ++ph;
    PHASE_BEGIN p0_prologue(F); PHASE_END
    PHASE_BEGIN norm_rows<0>(F); PHASE_END
    PHASE_BEGIN
        { Gemm g{F.HLAT, F.WIN, M, 4096, D}; StaticOrder S; S.init(M, 4096, F.G, cid); pg8::EpiInMain E{F.UX, F.UY, F.UG};
          pg8::gemm_phase<pg8::EpiInMain, StaticOrder, true, true>(F.lds + RING_OFF, g, S, E); }
        { Gemm g{F.WIN + (size_t)4096 * D, F.HLAT, 1024, M, D}; StaticOrder S; S.init(1024, M, F.G, cid); pg8::EpiPQT E{F.PQT};
          pg8::gemm_phase<pg8::EpiPQT, StaticOrder, true, true>(F.lds + RING_OFF, g, S, E); }
        { Gemm g{F.HCTX, F.WIN, MC, 1024, D}; StaticOrder S; S.init(MC, 1024, F.G, cid); pg8::EpiBf16<0> E{F.UXC, D};
          pg8::gemm_phase<pg8::EpiBf16<0>, StaticOrder, true, true>(F.lds + RING_OFF, g, S, E); }
    PHASE_END
    PHASE_BEGIN conv_phase(F); PHASE_END
    PHASE_BEGIN scan_phase(F, rep + 1 < REPS(ph) ? F.UX : F.UY); PHASE_END
    PHASE_BEGIN
        Gemm g{F.DFTM, F.PQT, T, NB * FW, 2 * T}; StaticOrder S; S.init(T, NB * FW, F.G, cid); pg8::EpiDft E{F.YF};
        pg8::gemm_phase<pg8::EpiDft, StaticOrder, true, true>(F.lds + RING_OFF, g, S, E);
    PHASE_END
    PHASE_BEGIN
        Gemm g{F.YF, F.WF, M, D, FW}; StaticOrder S; S.init(M, D, F.G, cid); pg8::EpiGate<false> E{F.YB, D, F.UG + 1024, 2048, nullptr};
        pg8::gemm_phase<pg8::EpiGate<false>, StaticOrder, true, true>(F.lds + RING_OFF, g, S, E);
    PHASE_END
    PHASE_BEGIN
        Gemm g{F.UY, F.WL, M, D, D}; StaticOrder S; S.init(M, D, F.G, cid); pg8::EpiGate<true> E{F.UX, D, F.UG, 2048, F.YB};
        pg8::gemm_phase<pg8::EpiGate<true>, StaticOrder, true, true>(F.lds + RING_OFF, g, S, E);
    PHASE_END
    PHASE_BEGIN
        Gemm g{F.UX, F.WOUT, M, D, D}; StaticOrder S; S.init(M, D, F.G, cid); pg8::EpiResid<0> E{F.x, F.out, F.MODF + 2048, F.POS};
        pg8::gemm_phase<pg8::EpiResid<0>, StaticOrder, true, true>(F.lds + RING_OFF, g, S, E);
    PHASE_END
    PHASE_BEGIN norm_rows<1>(F); PHASE_END
    PHASE_BEGIN
        Gemm g{F.UY, F.W1T, M, FF, D}; StaticOrder S; S.init(M, FF, F.G, cid); pg8::EpiBf16<1> E{F.HID, FF};
        pg8::gemm_phase<pg8::EpiBf16<1>, StaticOrder, true, true>(F.lds + RING_OFF, g, S, E);
    PHASE_END
    PHASE_BEGIN
        Gemm g{F.HID, F.W2T, M, D, FF}; StaticOrder S; S.init(M, D, F.G, cid); pg8::EpiResid<1> E{nullptr, F.out, F.MODF + 5120, nullptr};
        pg8::gemm_phase<pg8::EpiResid<1>, StaticOrder, true, true>(F.lds + RING_OFF, g, S, E);
    PHASE_END
    PHASE_BEGIN norm_rows<2>(F); PHASE_END
#undef IN
#undef SEAM
}

extern "C" void kernel_launch(void* const* d_in, const int* in_sizes, int n_in, void* d_out, int out_size, void* d_ws, size_t ws_size, hipStream_t stream) {
    static int grid = 0;
    if (grid == 0) {
        if (n_in != 22 || in_sizes[0] != M * D || out_size != M * D || ws_size < WS_END) { fprintf(stderr, "kernel_launch: unexpected shapes (n_in %d, in0 %d, out %d, ws %zu); nothing launched\n", n_in, n_in > 0 ? in_sizes[0] : -1, out_size, ws_size); grid = -1; return; }
        int dev = 0, cus = 0, per_cu = 0;
        if (hipGetDevice(&dev) != hipSuccess || hipDeviceGetAttribute(&cus, hipDeviceAttributeMultiprocessorCount, dev) != hipSuccess) { fprintf(stderr, "kernel_launch: device query failed\n"); grid = -1; return; }
        if (hipFuncSetAttribute((const void*)mk_fwd, hipFuncAttributeMaxDynamicSharedMemorySize, LDS_BYTES) != hipSuccess) { fprintf(stderr, "kernel_launch: hipFuncSetAttribute failed\n"); grid = -1; return; }
        if (hipOccupancyMaxActiveBlocksPerMultiprocessor(&per_cu, (const void*)mk_fwd, NWAVES * 64, LDS_BYTES) != hipSuccess || per_cu < 1) { fprintf(stderr, "kernel_launch: occupancy query reports %d workgroups per CU\n", per_cu); (void)hipGetLastError(); grid = -1; return; }
        grid = cus;
    }
    if (grid < 0) return;
    if (hipMemsetAsync((char*)d_ws + WS_CTL, 0, CTL_ZERO_BYTES, stream) != hipSuccess) { fprintf(stderr, "kernel_launch: hipMemsetAsync failed\n"); return; }
    Args a{};
    for (int i = 0; i < 22; ++i) a.in[i] = (const float*)d_in[i];
    a.out = (float*)d_out; a.ws = (unsigned char*)d_ws;
    if (N_LAUNCHES == 1) {
        a.ph_lo = 0; a.ph_hi = N_PHASES;
        void* kargs[] = {&a};
        const hipError_t le = hipLaunchCooperativeKernel((const void*)mk_fwd, dim3(grid), dim3(NWAVES * 64), kargs, LDS_BYTES, stream);
        if (le != hipSuccess) fprintf(stderr, "kernel_launch: cooperative launch failed: %s (grid %d)\n", hipGetErrorName(le), grid);
    } else {
        for (int li = 0; li < N_PHASES; ++li) {
            a.ph_lo = li; a.ph_hi = li + 1;
            hipLaunchKernelGGL(mk_fwd, dim3(grid), dim3(NWAVES * 64), LDS_BYTES, stream, a);
            const hipError_t le = hipPeekAtLastError();
            if (le != hipSuccess) { fprintf(stderr, "kernel_launch: launch %d failed: %s\n", li, hipGetErrorName(le)); break; }
        }
    }
}
```

```cpp
#include <hip/hip_runtime.h>
#include <cstdio>
#include <cstdint>
#define MK_N_LAUNCHES 1
namespace pg8 {
#define PG8_LAS __attribute__((address_space(3)))
typedef unsigned short bf16_t;
typedef short bf16x8 __attribute__((ext_vector_type(8)));
typedef float f32x4 __attribute__((ext_vector_type(4)));
typedef unsigned u32x4 __attribute__((ext_vector_type(4)));
constexpr int BM = 256, BK = 64, HALF = 128, HTB = HALF * BK * 2  , STAGE_BYTES = 8 * HTB, NXCD = 8, WGM = 8;

__host__ __device__ __forceinline__ int lds_byte(int r, int c) { const int st = (r >> 4) * 2 + (c >> 5), rr = r & 15, cc = c & 31, ob = rr * 64 + cc * 2; return st * 1024 + (ob ^ (((ob >> 9) & 1) << 5)); }
__host__ __device__ __forceinline__ void stage_rc(int b, int& R, int& C) { const int st = b / 1024, sb = b % 1024, swz = sb ^ (((sb >> 9) & 1) << 5); R = (st >> 1) * 16 + swz / 64; C = (st & 1) * 32 + (swz % 64) / 2; }
__host__ __device__ __forceinline__ int perm32(int rho) { const int n = rho >> 4, i = rho & 15; return 8 * (i >> 2) + 4 * n + (i & 3); }

struct Unit { int pm, pn; };
struct Gemm { const bf16_t* A; const bf16_t* Bt; int M, N, K; };

struct StaticOrder {
    int nM, nN, nwg, G, c;
    __host__ __device__ void init(int M, int N, int G_, int c_) { nM = M / BM; nN = N / BM; nwg = nM * nN; G = G_; c = c_; }
    __host__ __device__ bool next(int i, Unit& u) const {
        const long L = (long)i * G + c; if (L >= nwg) return false;
        int wgid = (int)L; { const int q = nwg / NXCD, r = nwg % NXCD, xcd = wgid % NXCD, off = wgid / NXCD; wgid = (xcd < r ? xcd * (q + 1) : r * (q + 1) + (xcd - r) * q) + off; }
        const int nig = WGM * nN, gid = wgid / nig, fm = gid * WGM, gsz = (nM - fm) < WGM ? (nM - fm) : WGM;
        u.pm = fm + ((wgid % nig) % gsz); u.pn = (wgid % nig) / gsz; return true;
    }
    __device__ __forceinline__ void a_ready(const Unit&) const {}
    __device__ __forceinline__ void done(const Unit&) const {}
};

__device__ __forceinline__ unsigned cvt_pk_bf16(float lo, float hi) { unsigned r; asm volatile("v_cvt_pk_bf16_f32 %0, %1, %2" : "=v"(r) : "v"(lo), "v"(hi)); return r; }
__device__ __forceinline__ float bf_lo(unsigned w) { return __uint_as_float(w << 16); }
__device__ __forceinline__ float bf_hi(unsigned w) { return __uint_as_float(w & 0xffff0000u); }
__device__ __forceinline__ float sigm(float x) { return __builtin_amdgcn_rcpf(1.0f + __expf(-x)); }
__device__ __forceinline__ float gelu_tanh(float x) { const float z = 1.5957691216f * (x + 0.044715f * x * x * x); return x * sigm(z); }
__device__ __forceinline__ u32x4 pack8(const f32x4 v0, const f32x4 v1) { u32x4 w; w.x = cvt_pk_bf16(v0[0], v0[1]); w.y = cvt_pk_bf16(v0[2], v0[3]); w.z = cvt_pk_bf16(v1[0], v1[1]); w.w = cvt_pk_bf16(v1[2], v1[3]); return w; }

struct EpiInMain {
    static constexpr bool PERM = true, AFTER_DRAIN = false;
    bf16_t* UX; bf16_t* UY; bf16_t* UG;
    __device__ __forceinline__ void operator()(const f32x4 (&acc)[2][2][4][2], const Unit& u, int wr, int wc, int fr, int fq) const {
        const int row0 = u.pm * BM + wr * 64 + fr; const int ct = u.pn * BM;
        bf16_t* base; int ldc, colt, act;
        if (ct < 1024) { base = UX; ldc = 1024; colt = ct; act = 0; }
        else if (ct < 2048) { base = UY; ldc = 1024; colt = ct - 1024; act = 1; }
        else { base = UG; ldc = 2048; colt = ct - 2048; act = 2; }
        const int col0 = colt + wc * 32 + 8 * fq;
#pragma unroll
        for (int ai = 0; ai < 2; ++ai)
#pragma unroll
            for (int m = 0; m < 4; ++m) { bf16_t* rowp = base + (size_t)(row0 + ai * HALF + m * 16) * ldc + col0;
#pragma unroll
                for (int bj = 0; bj < 2; ++bj) { f32x4 v0 = acc[ai][bj][m][0], v1 = acc[ai][bj][m][1];
                    if (act == 1) {
#pragma unroll
                        for (int j = 0; j < 4; ++j) { v0[j] = gelu_tanh(v0[j]); v1[j] = gelu_tanh(v1[j]); } }
                    if (act == 2) {
#pragma unroll
                        for (int j = 0; j < 4; ++j) { v0[j] = sigm(v0[j]); v1[j] = sigm(v1[j]); } }
                    *(u32x4*)(rowp + bj * HALF) = pack8(v0, v1); } }
    }
};
template <int ACT  > struct EpiBf16 {
    static constexpr bool PERM = true, AFTER_DRAIN = false;
    bf16_t* O; int ldc;
    __device__ __forceinline__ void operator()(const f32x4 (&acc)[2][2][4][2], const Unit& u, int wr, int wc, int fr, int fq) const {
        const int row0 = u.pm * BM + wr * 64 + fr; const int col0 = u.pn * BM + wc * 32 + 8 * fq;
#pragma unroll
        for (int ai = 0; ai < 2; ++ai)
#pragma unroll
            for (int m = 0; m < 4; ++m) { bf16_t* rowp = O + (size_t)(row0 + ai * HALF + m * 16) * ldc + col0;
#pragma unroll
                for (int bj = 0; bj < 2; ++bj) { f32x4 v0 = acc[ai][bj][m][0], v1 = acc[ai][bj][m][1];
                    if (ACT == 1) {
#pragma unroll
                        for (int j = 0; j < 4; ++j) { const float a = fmaxf(v0[j], 0.f), b = fmaxf(v1[j], 0.f); v0[j] = a * a; v1[j] = b * b; } }
                    *(u32x4*)(rowp + bj * HALF) = pack8(v0, v1); } }
    }
};
struct EpiPQT {
    static constexpr bool PERM = true, AFTER_DRAIN = false;
    bf16_t* PQT;
    __device__ __forceinline__ void operator()(const f32x4 (&acc)[2][2][4][2], const Unit& u, int wr, int wc, int fr, int fq) const {
        const int row0 = u.pm * BM + wr * 64 + fr; const int col0 = u.pn * BM + wc * 32 + 8 * fq;
#pragma unroll
        for (int ai = 0; ai < 2; ++ai)
#pragma unroll
            for (int m = 0; m < 4; ++m) { const int row = row0 + ai * HALF + m * 16; const int pq = row >> 9, j = row & 511;
#pragma unroll
                for (int bj = 0; bj < 2; ++bj) { const int col = col0 + bj * HALF; const int b = col >> 11, t = col & 2047;
                    bf16_t* p = PQT + (((size_t)(b * 512 + j) * 2 + pq) * 2048 + t);
                    *(u32x4*)p = pack8(acc[ai][bj][m][0], acc[ai][bj][m][1]); } }
    }
};
struct EpiDft {
    static constexpr bool PERM = true, AFTER_DRAIN = false;
    bf16_t* YF;
    __device__ __forceinline__ void operator()(const f32x4 (&acc)[2][2][4][2], const Unit& u, int wr, int wc, int fr, int fq) const {
        const int row0 = u.pm * BM + wr * 64 + fr; const int col0 = u.pn * BM + wc * 32 + 8 * fq;
#pragma unroll
        for (int ai = 0; ai < 2; ++ai)
#pragma unroll
            for (int m = 0; m < 4; ++m) { const int k = row0 + ai * HALF + m * 16;
#pragma unroll
                for (int bj = 0; bj < 2; ++bj) { const int col = col0 + bj * HALF; const int b = col >> 9, j = col & 511;
                    bf16_t* p = YF + ((size_t)(b * 2048 + k) * 512 + j);
                    *(u32x4*)p = pack8(acc[ai][bj][m][0], acc[ai][bj][m][1]); } }
    }
};
template <bool HAS_ADD> struct EpiGate {
    static constexpr bool PERM = true, AFTER_DRAIN = false;
    bf16_t* O; int ldc; const bf16_t* G; int ldg; const bf16_t* ADD;
    __device__ __forceinline__ void operator()(const f32x4 (&acc)[2][2][4][2], const Unit& u, int wr, int wc, int fr, int fq) const {
        const int row0 = u.pm * BM + wr * 64 + fr; const int col0 = u.pn * BM + wc * 32 + 8 * fq;
#pragma unroll
        for (int ai = 0; ai < 2; ++ai)
#pragma unroll
            for (int m = 0; m < 4; ++m) { const size_t row = (size_t)(row0 + ai * HALF + m * 16);
#pragma unroll
                for (int bj = 0; bj < 2; ++bj) { const int col = col0 + bj * HALF;
                    const u32x4 g = *(const u32x4*)(G + row * ldg + col);
                    f32x4 v0 = acc[ai][bj][m][0], v1 = acc[ai][bj][m][1];
                    v0[0] *= bf_lo(g.x); v0[1] *= bf_hi(g.x); v0[2] *= bf_lo(g.y); v0[3] *= bf_hi(g.y);
                    v1[0] *= bf_lo(g.z); v1[1] *= bf_hi(g.z); v1[2] *= bf_lo(g.w); v1[3] *= bf_hi(g.w);
                    if (HAS_ADD) { const u32x4 a = *(const u32x4*)(ADD + row * ldc + col);
                        v0[0] += bf_lo(a.x); v0[1] += bf_hi(a.x); v0[2] += bf_lo(a.y); v0[3] += bf_hi(a.y);
                        v1[0] += bf_lo(a.z); v1[1] += bf_hi(a.z); v1[2] += bf_lo(a.w); v1[3] += bf_hi(a.w); }
                    *(u32x4*)(O + row * ldc + col) = pack8(v0, v1); } }
    }
};
template <int MODE> struct EpiResid {
    static constexpr bool PERM = false, AFTER_DRAIN = false;
    const float* X; float* O; const float* gate  ; const float* pos  ;
    __device__ __forceinline__ void operator()(const f32x4 (&acc)[2][2][4][2], const Unit& u, int wr, int wc, int fr, int fq) const {
        const int row0 = u.pm * BM + wr * 64 + fr, col0 = u.pn * BM + wc * 32 + 4 * fq;
#pragma unroll
        for (int ai = 0; ai < 2; ++ai)
#pragma unroll
            for (int m = 0; m < 4; ++m) { const int row = row0 + ai * HALF + m * 16; const int b = row >> 11, t = row & 2047;
#pragma unroll
                for (int bj = 0; bj < 2; ++bj)
#pragma unroll
                    for (int n = 0; n < 2; ++n) { const int c = col0 + bj * HALF + n * 16;
                        const f32x4 gt = *(const f32x4*)(gate + (size_t)b * 6144 + c);
                        f32x4 base;
                        if (MODE == 0) { const f32x4 pv = (c < 512) ? *(const f32x4*)(pos + (t >> 6) * 512 + c) : *(const f32x4*)(pos + 32 * 512 + (t & 63) * 512 + (c - 512));
                            base = *(const f32x4*)(X + (size_t)row * 1024 + c) + pv; }
                        else base = *(const f32x4*)(O + (size_t)row * 1024 + c);
                        *(f32x4*)(O + (size_t)row * 1024 + c) = base + gt * acc[ai][bj][m][n]; }
                asm volatile("" ::: "memory"); }
    }
};

template <class Epi, class Sched, bool ALIGN_EPI = false, bool SP2 = false>
__device__ __forceinline__ void gemm_phase(PG8_LAS unsigned char* lds, const Gemm g, const Sched& S, const Epi& E) {
    const int tid = threadIdx.x, wid = __builtin_amdgcn_readfirstlane(tid >> 6), lane = tid & 63, wr = wid >> 2, wc = wid & 3, fr = lane & 15, fq = lane >> 4;
    const int K = g.K, nt = K / BK;
    unsigned voffA[2], voffB[2];
#pragma unroll
    for (int i = 0; i < 2; ++i) { int R, C; stage_rc(tid * 16 + i * 8192, R, C); const int Rb = Epi::PERM ? ((R & ~31) + perm32(R & 31)) : R;
        voffA[i] = (unsigned)(R * K + C) * 2u; voffB[i] = (unsigned)(Rb * K + C) * 2u; }
    const size_t kstep = (size_t)(BK * 2);
    const size_t hstep = (size_t)HALF * K * 2;
    const size_t tstep = 2 * hstep;
    const unsigned ldsw = (unsigned)wid * 1024u;
    const int aoff = lds_byte(wr * 64 + fr, fq * 8), boff = lds_byte(wc * 32 + fr, fq * 8);
#define PG8_SA(b, h) (((b) * 2 + (h)) * HTB)
#define PG8_SB(b, h) ((4 + (b) * 2 + (h)) * HTB)
#define PG8_STAGE(bufoff, gbase, voff) do { _Pragma("unroll") for (int _i = 0; _i < 2; ++_i) \
        __builtin_amdgcn_global_load_lds((const unsigned*)((const char*)(gbase) + (voff)[_i]), (PG8_LAS unsigned*)(lds + (bufoff) + ldsw + _i * 8192), 16, 0, 0); } while (0)
#define PG8_LDA(dst, b, h) do { _Pragma("unroll") for (int m = 0; m < 4; ++m) _Pragma("unroll") for (int k = 0; k < 2; ++k) dst[m][k] = *(const PG8_LAS bf16x8*)(lds + PG8_SA(b, h) + aoff + m * 2048 + k * 1024); } while (0)
#define PG8_LDB(dst, b, h) do { _Pragma("unroll") for (int n = 0; n < 2; ++n) _Pragma("unroll") for (int k = 0; k < 2; ++k) dst[n][k] = *(const PG8_LAS bf16x8*)(lds + PG8_SB(b, h) + boff + n * 2048 + k * 1024); } while (0)
#define PG8_MMA(ai, bj, At, Bt) do { __builtin_amdgcn_s_setprio(1); _Pragma("unroll") for (int m = 0; m < 4; ++m) _Pragma("unroll") for (int n = 0; n < 2; ++n) _Pragma("unroll") for (int k = 0; k < 2; ++k) \
        acc[ai][bj][m][n] = __builtin_amdgcn_mfma_f32_16x16x32_bf16(Bt[n][k], At[m][k], acc[ai][bj][m][n], 0, 0, 0); __builtin_amdgcn_s_setprio(0); } while (0)
#define PG8_WAIT_V(n) asm volatile("s_waitcnt vmcnt(" #n ")" ::: "memory")
#define PG8_WAIT_L(n) asm volatile("s_waitcnt lgkmcnt(" #n ")" ::: "memory")
#define PG8_BAR __builtin_amdgcn_s_barrier()
#define PG8_SCHED __builtin_amdgcn_sched_barrier(0)
    Unit cur, nxt; int ui = 0;
    if (!S.next(0, cur)) return;
    f32x4 acc[2][2][4][2];
#pragma unroll
    for (int a = 0; a < 2; ++a)
#pragma unroll
        for (int b = 0; b < 2; ++b)
#pragma unroll
            for (int m = 0; m < 4; ++m)
#pragma unroll
                for (int n = 0; n < 2; ++n) acc[a][b][m][n] = (f32x4){0.f, 0.f, 0.f, 0.f};
    bf16x8 At[4][2], B0[2][2], B1[2][2];
    const char* cA = (const char*)g.A + (size_t)cur.pm * tstep; const char* cB = (const char*)g.Bt + (size_t)cur.pn * tstep;
    S.a_ready(cur);
    if constexpr (SP2) {
        PG8_STAGE(PG8_SB(0, 0), cB, voffB); PG8_STAGE(PG8_SB(0, 1), cB + hstep, voffB); PG8_STAGE(PG8_SA(0, 0), cA, voffA); PG8_STAGE(PG8_SA(0, 1), cA + hstep, voffA);
        if (wr == 1) PG8_BAR;
        PG8_WAIT_V(2); PG8_BAR;
        PG8_STAGE(PG8_SB(1, 0), cB + kstep, voffB); PG8_STAGE(PG8_SA(1, 0), cA + kstep, voffA); PG8_STAGE(PG8_SB(1, 1), cB + hstep + kstep, voffB);
        PG8_WAIT_V(6); PG8_BAR;
    } else {
        PG8_STAGE(PG8_SB(0, 0), cB, voffB); PG8_STAGE(PG8_SA(0, 0), cA, voffA); PG8_STAGE(PG8_SB(0, 1), cB + hstep, voffB); PG8_STAGE(PG8_SA(0, 1), cA + hstep, voffA);
        if (wr == 1) PG8_BAR;
        PG8_WAIT_V(4); PG8_BAR;
        PG8_STAGE(PG8_SB(1, 0), cB + kstep, voffB); PG8_STAGE(PG8_SA(1, 0), cA + kstep, voffA); PG8_STAGE(PG8_SB(1, 1), cB + hstep + kstep, voffB);
        PG8_WAIT_V(6); PG8_BAR;
    }
    for (;;) {
        const bool has_next = S.next(ui + 1, nxt);
        const char* nA = has_next ? (const char*)g.A + (size_t)nxt.pm * tstep : cA; const char* nB = has_next ? (const char*)g.Bt + (size_t)nxt.pn * tstep : cB;
        for (int t = 0; t < nt; t += 2) {
            const bool last = (t == nt - 2);
            const char* a1 = cA + (size_t)(t + 1) * kstep;
            const char* a2 = last ? nA : cA + (size_t)(t + 2) * kstep; const char* b2 = last ? nB : cB + (size_t)(t + 2) * kstep;
            const char* a3 = a2 + kstep; const char* b3 = b2 + kstep;
            if (last && has_next) S.a_ready(nxt);
            if constexpr (SP2) {
            PG8_LDB(B0, 0, 0); PG8_LDB(B1, 0, 1); PG8_SCHED; PG8_LDA(At, 0, 0); PG8_STAGE(PG8_SA(1, 1), a1 + hstep, voffA);
            PG8_WAIT_V(8); PG8_WAIT_L(0); PG8_BAR; PG8_MMA(0, 0, At, B0); PG8_MMA(0, 1, At, B1); PG8_BAR; PG8_SCHED;
            PG8_LDA(At, 0, 1); PG8_STAGE(PG8_SB(0, 0), b2, voffB); PG8_STAGE(PG8_SB(0, 1), b2 + hstep, voffB); PG8_STAGE(PG8_SA(0, 0), a2, voffA);
            PG8_WAIT_V(8); PG8_WAIT_L(0); PG8_BAR; PG8_MMA(1, 0, At, B0); PG8_MMA(1, 1, At, B1); PG8_BAR; PG8_SCHED;
            PG8_LDB(B0, 1, 0); PG8_LDB(B1, 1, 1); PG8_SCHED; PG8_LDA(At, 1, 0); PG8_STAGE(PG8_SA(0, 1), a2 + hstep, voffA);
            PG8_WAIT_V(8); PG8_WAIT_L(0); PG8_BAR; PG8_MMA(0, 0, At, B0); PG8_MMA(0, 1, At, B1); PG8_BAR; PG8_SCHED;
            PG8_LDA(At, 1, 1); PG8_STAGE(PG8_SB(1, 0), b3, voffB); PG8_STAGE(PG8_SB(1, 1), b3 + hstep, voffB); PG8_STAGE(PG8_SA(1, 0), a3, voffA);
            PG8_WAIT_V(8); PG8_WAIT_L(0); PG8_BAR; PG8_MMA(1, 0, At, B0); PG8_MMA(1, 1, At, B1); PG8_BAR; PG8_SCHED;
            } else {
            PG8_LDB(B0, 0, 0); PG8_SCHED; PG8_LDA(At, 0, 0); PG8_STAGE(PG8_SA(1, 1), a1 + hstep, voffA);
            PG8_WAIT_L(8); PG8_BAR; PG8_WAIT_L(0); PG8_MMA(0, 0, At, B0); PG8_BAR; PG8_SCHED;
            PG8_LDB(B1, 0, 1); PG8_STAGE(PG8_SB(0, 0), b2, voffB);
            PG8_BAR; PG8_WAIT_L(0); PG8_MMA(0, 1, At, B1); PG8_BAR;
            PG8_LDA(At, 0, 1); PG8_STAGE(PG8_SA(0, 0), a2, voffA);
            PG8_BAR; PG8_WAIT_L(0); PG8_MMA(1, 0, At, B0); PG8_BAR; PG8_SCHED;
            PG8_STAGE(PG8_SB(0, 1), b2 + hstep, voffB);
            PG8_WAIT_V(6); PG8_BAR; PG8_MMA(1, 1, At, B1); PG8_BAR;
            PG8_LDB(B0, 1, 0); PG8_SCHED; PG8_LDA(At, 1, 0); PG8_STAGE(PG8_SA(0, 1), a2 + hstep, voffA);
            PG8_WAIT_L(8); PG8_BAR; PG8_WAIT_L(0); PG8_MMA(0, 0, At, B0); PG8_BAR; PG8_SCHED;
            PG8_LDB(B1, 1, 1); PG8_STAGE(PG8_SB(1, 0), b3, voffB);
            PG8_BAR; PG8_WAIT_L(0); PG8_MMA(0, 1, At, B1); PG8_BAR;
            PG8_LDA(At, 1, 1); PG8_STAGE(PG8_SA(1, 0), a3, voffA);
            PG8_BAR; PG8_WAIT_L(0); PG8_MMA(1, 0, At, B0); PG8_BAR; PG8_SCHED;
            PG8_STAGE(PG8_SB(1, 1), b3 + hstep, voffB);
            PG8_WAIT_V(6); PG8_BAR; PG8_MMA(1, 1, At, B1); PG8_BAR;
            }
        }
        if constexpr (ALIGN_EPI) { if (wr == 0) PG8_BAR; }
        if constexpr (!Epi::AFTER_DRAIN) { E(acc, cur, wr, wc, fr, fq); S.done(cur); }
        if (!has_next) break;
#pragma unroll
        for (int a = 0; a < 2; ++a)
#pragma unroll
            for (int b = 0; b < 2; ++b)
#pragma unroll
                for (int m = 0; m < 4; ++m)
#pragma unroll
                    for (int n = 0; n < 2; ++n) acc[a][b][m][n] = (f32x4){0.f, 0.f, 0.f, 0.f};
        cur = nxt; cA = nA; cB = nB; ++ui;
        if constexpr (ALIGN_EPI) { if (wr == 1) PG8_BAR; }
    }
    PG8_WAIT_V(0);
    if constexpr (!ALIGN_EPI) { if (wr == 0) PG8_BAR; }
    PG8_BAR;
    if constexpr (Epi::AFTER_DRAIN) { E.fused(acc, cur, wr, wc, fr, fq, lds, wid, lane); S.done(cur); }
#undef PG8_SA
#undef PG8_SB
#undef PG8_STAGE
#undef PG8_LDA
#undef PG8_LDB
#undef PG8_MMA
#undef PG8_WAIT_V
#undef PG8_WAIT_L
#undef PG8_BAR
#undef PG8_SCHED
}
}
#define PG8_SP2 true

constexpr int NWAVES = 8;
#ifndef MK_N_LAUNCHES
#define MK_N_LAUNCHES 1
#endif
constexpr int N_PHASES = 13;
constexpr int N_LAUNCHES = MK_N_LAUNCHES;

constexpr int NB = 8, T = 2048, D = 1024, M = NB * T, CT = 256, MC = NB * CT, FW = 512, FF = 4096, NMOD = 6 * D;
constexpr float EPS = 1e-6f;

constexpr size_t MiB = 1u << 20;
constexpr size_t WS_CTL = 0, CTL_ZERO_BYTES = 64 * 1024;
constexpr size_t WS_MODF = 1 * MiB;
constexpr size_t WS_POS = 1 * MiB + 256 * 1024;
constexpr size_t WS_WIN = 2 * MiB;
constexpr size_t WS_W1 = 12 * MiB, WS_W2 = 20 * MiB, WS_WOUT = 28 * MiB, WS_WL = 30 * MiB, WS_WF = 32 * MiB, WS_WG = 33 * MiB;
constexpr size_t WS_HCTX = 34 * MiB, WS_UXC = 38 * MiB;
constexpr size_t WS_HLAT = 48 * MiB;
constexpr size_t WS_UX = 80 * MiB;
constexpr size_t WS_PQT = 112 * MiB;
constexpr size_t WS_YF = 144 * MiB;
constexpr size_t WS_DFTM = 160 * MiB;
constexpr size_t WS_HID = 48 * MiB;
constexpr size_t WS_UY = 176 * MiB;
constexpr size_t WS_YB = 208 * MiB;
constexpr size_t WS_END = 240 * MiB;
constexpr int CW_BAR = 1024;

constexpr int RING_OFF = 0, RING_BYTES = 131072;
constexpr int LDSCTL_OFF = RING_BYTES, MISC_OFF = LDSCTL_OFF + 320;
constexpr int LDS_BYTES = 147456;
static_assert(MISC_OFF + 128 <= LDS_BYTES, "LDS map");

#define GAS __attribute__((address_space(1)))
#define LAS __attribute__((address_space(3)))
typedef unsigned short bf16;
typedef unsigned v4u __attribute__((ext_vector_type(4)));
typedef unsigned v2u __attribute__((ext_vector_type(2)));
typedef float f32x4 __attribute__((ext_vector_type(4)));
typedef float f32x16 __attribute__((ext_vector_type(16)));
typedef short bf16x8 __attribute__((ext_vector_type(8)));
typedef GAS unsigned gu32;
#define RLX_AGENT __ATOMIC_RELAXED, __HIP_MEMORY_SCOPE_AGENT
#define LDS_WAIT() asm volatile("s_waitcnt lgkmcnt(0)" ::: "memory")
#define VM_WAIT() asm volatile("s_waitcnt vmcnt(0)" ::: "memory")
#define CBAR() asm volatile("" ::: "memory")
__device__ __forceinline__ unsigned f2bf(float f) { unsigned u = __builtin_bit_cast(unsigned, f); return (u + 0x7fffu + ((u >> 16) & 1u)) >> 16; }
__device__ __forceinline__ unsigned pk2(float lo, float hi) { return f2bf(lo) | (f2bf(hi) << 16); }
__device__ __forceinline__ float bflo(unsigned w) { return __uint_as_float(w << 16); }
__device__ __forceinline__ float bfhi(unsigned w) { return __uint_as_float(w & 0xffff0000u); }
__device__ __forceinline__ float bf1(unsigned short h) { return __uint_as_float(((unsigned)h) << 16); }

#define XB_TMO      128
#define XB_XCNT(j)  (256  + 64 * (j))
#define XB_XSUB(j)  (1280 + 64 * (j))
#define XB_XGEN(j)  (2304 + 64 * (j))
#define XB_TOP      3328
#define XB_TOPGEN   3392
#define XCD_BAR_WORDS 3456
#define XB_SPIN_CAP (1u << 18)

__device__ __forceinline__ unsigned xb_ld(unsigned* p)              { return __hip_atomic_load(p, __ATOMIC_RELAXED, __HIP_MEMORY_SCOPE_AGENT); }
__device__ __forceinline__ unsigned xb_add(unsigned* p, unsigned v) { return __hip_atomic_fetch_add(p, v, __ATOMIC_RELAXED, __HIP_MEMORY_SCOPE_AGENT); }
__device__ __forceinline__ unsigned xb_xcc_id() { return (unsigned)__builtin_amdgcn_s_getreg((3 << 11) | 20) & 0xFu; }
#define XB_SPIN(cond, bar) do { unsigned _sp = 0; while (cond) { __builtin_amdgcn_s_sleep(1); \
    if ((++_sp & 255u) == 0u) { if (xb_ld(&(bar)[XB_TMO])) break; if (_sp > XB_SPIN_CAP) { atomicAdd(&(bar)[XB_TMO], 1u); break; } } } } while (0)

struct XcdBarrier {
    unsigned* bar; unsigned x;
    volatile LAS unsigned* st;
};

__device__ __forceinline__ XcdBarrier xcd_barrier_post(unsigned* bar, volatile LAS unsigned* st) {
    XcdBarrier b; b.bar = bar; b.x = xb_xcc_id(); b.st = st;
    if (threadIdx.x == 0) (void)xb_add(&bar[XB_XCNT(b.x)], 1u);
    return b;
}
__device__ __forceinline__ void xcd_barrier_complete(unsigned* bar, unsigned x, unsigned& nloc, unsigned& nx) {
    const unsigned G = gridDim.x * gridDim.y * gridDim.z;
    unsigned sum, cnt, mine, sp = 0u;
    for (;;) {
        sum = 0u; cnt = 0u; mine = 0u;
#pragma unroll
        for (unsigned j = 0; j < 16; ++j) { const unsigned c = xb_ld(&bar[XB_XCNT(j)]); sum += c; cnt += (c > 0u) ? 1u : 0u; mine = (j == x) ? c : mine; }
        if (sum == G) break;
        __builtin_amdgcn_s_sleep(1);
        if ((++sp & 255u) == 0u) { if (xb_ld(&bar[XB_TMO])) break; if (sp > XB_SPIN_CAP) { atomicAdd(&bar[XB_TMO], 1u); break; } }
    }
    nloc = mine > 0u ? mine : 1u; nx = cnt > 0u ? cnt : 1u;
}

__device__ __forceinline__ void xcd_barrier(const XcdBarrier& b) {
    asm volatile("s_waitcnt vmcnt(0)" ::: "memory");
    __syncthreads();
    if (threadIdx.x == 0) {
        unsigned* bar = b.bar;
        __builtin_amdgcn_s_waitcnt(0);
        unsigned nloc = b.st[0], nx = b.st[1];
        if (nloc == 0u) { xcd_barrier_complete(bar, b.x, nloc, nx); b.st[0] = nloc; b.st[1] = nx; }
        const unsigned old = xb_add(&bar[XB_XSUB(b.x)], 1u);
        const unsigned gen = old / nloc;
        if (old + 1u == (gen + 1u) * nloc) {
            __builtin_amdgcn_fence(__ATOMIC_RELEASE, "agent");
            asm volatile("s_waitcnt vmcnt(0)" ::: "memory");
            const unsigned og = xb_add(&bar[XB_TOP], 1u);
            const unsigned tg = og / nx;
            if (og + 1u == (tg + 1u) * nx) xb_add(&bar[XB_TOPGEN], 1u);
            else XB_SPIN(xb_ld(&bar[XB_TOPGEN]) == tg, bar);
            __builtin_amdgcn_fence(__ATOMIC_ACQUIRE, "agent");
            xb_add(&bar[XB_XGEN(b.x)], 1u);
            asm volatile("s_waitcnt vmcnt(0)" ::: "memory");
        } else {
            XB_SPIN(xb_ld(&bar[XB_XGEN(b.x)]) == gen, bar);
            __builtin_amdgcn_fence(__ATOMIC_ACQUIRE, "agent");
            asm volatile("s_waitcnt vmcnt(0)" ::: "memory");
        }
    }
    __syncthreads();
}

struct Frame {
    LAS unsigned char* lds;
    volatile LAS unsigned* MISC;
    gu32* ctl;
    int tid, lane, wave;
    int vcu, G;
    const float *x, *c, *ctx, *c_ctx, *w_mod, *b_mod, *g_mix, *w_in, *conv_w, *conv_b, *w_a, *b_a, *w_x, *b_x, *lam, *w_lru_out, *w_f_out, *w_out, *g_mlp, *w1, *w2, *g_final;
    float* out;
    float *MODF, *POS;
    bf16 *WIN, *W1T, *W2T, *WOUT, *WL, *WF, *WG, *HCTX, *UXC, *HLAT, *UX, *PQT, *YF, *DFTM, *HID, *UY, *YB, *UG, *XC, *XCC;
};

__device__ __forceinline__ float wave_sum(float v) {
#pragma unroll
    for (int o = 1; o < 64; o <<= 1) v += __shfl_xor(v, o);
    return v;
}
__device__ __forceinline__ float sigm(float x) { return __builtin_amdgcn_rcpf(1.0f + __expf(-x)); }

__device__ __forceinline__ void p0_transpose_item(const float* W, int K, int ldw, int col0, int nblk, bf16* WT, int row_off, LAS float* scr, int item, int lane) {
    const int kb = item / nblk, nb = item % nblk, k0 = 64 * kb, n0 = 32 * nb;
    float tv[32];
#pragma unroll
    for (int i = 0; i < 32; ++i) { const int kk = 2 * i + (lane >> 5); tv[i] = W[(size_t)(k0 + kk) * ldw + col0 + n0 + (lane & 31)]; }
#pragma unroll
    for (int i = 0; i < 32; ++i) { const int kk = 2 * i + (lane >> 5); scr[kk * 33 + (lane & 31)] = tv[i]; }
    LDS_WAIT(); CBAR();
    const int c = lane & 7;
#pragma unroll
    for (int j = 0; j < 4; ++j) { const int n = (lane >> 3) + 8 * j; const LAS float* s = scr + (8 * c) * 33 + n;
        v4u o; o.x = pk2(s[0 * 33], s[1 * 33]); o.y = pk2(s[2 * 33], s[3 * 33]); o.z = pk2(s[4 * 33], s[5 * 33]); o.w = pk2(s[6 * 33], s[7 * 33]);
        *(v4u*)(WT + (size_t)(row_off + n0 + n) * K + k0 + 8 * c) = o; }
    LDS_WAIT(); CBAR();
}

__constant__ float c_trig128[256] = { 1.000000000e+00f, 9.987954562e-01f, 9.951847267e-01f, 9.891765100e-01f, 9.807852804e-01f, 9.700312532e-01f, 9.569403357e-01f, 9.415440652e-01f, 9.238795325e-01f, 9.039892931e-01f, 8.819212643e-01f, 8.577286100e-01f, 8.314696123e-01f, 8.032075315e-01f, 7.730104534e-01f, 7.409511254e-01f, 7.071067812e-01f, 6.715589548e-01f, 6.343932842e-01f, 5.956993045e-01f, 5.555702330e-01f, 5.141027442e-01f, 4.713967368e-01f, 4.275550934e-01f, 3.826834324e-01f, 3.368898534e-01f, 2.902846773e-01f, 2.429801799e-01f, 1.950903220e-01f, 1.467304745e-01f, 9.801714033e-02f, 4.906767433e-02f, 6.123233996e-17f, -4.906767433e-02f, -9.801714033e-02f, -1.467304745e-01f, -1.950903220e-01f, -2.429801799e-01f, -2.902846773e-01f, -3.368898534e-01f, -3.826834324e-01f, -4.275550934e-01f, -4.713967368e-01f, -5.141027442e-01f, -5.555702330e-01f, -5.956993045e-01f, -6.343932842e-01f, -6.715589548e-01f, -7.071067812e-01f, -7.409511254e-01f, -7.730104534e-01f, -8.032075315e-01f, -8.314696123e-01f, -8.577286100e-01f, -8.819212643e-01f, -9.039892931e-01f, -9.238795325e-01f, -9.415440652e-01f, -9.569403357e-01f, -9.700312532e-01f, -9.807852804e-01f, -9.891765100e-01f, -9.951847267e-01f, -9.987954562e-01f, -1.000000000e+00f, -9.987954562e-01f, -9.951847267e-01f, -9.891765100e-01f, -9.807852804e-01f, -9.700312532e-01f, -9.569403357e-01f, -9.415440652e-01f, -9.238795325e-01f, -9.039892931e-01f, -8.819212643e-01f, -8.577286100e-01f, -8.314696123e-01f, -8.032075315e-01f, -7.730104534e-01f, -7.409511254e-01f, -7.071067812e-01f, -6.715589548e-01f, -6.343932842e-01f, -5.956993045e-01f, -5.555702330e-01f, -5.141027442e-01f, -4.713967368e-01f, -4.275550934e-01f, -3.826834324e-01f, -3.368898534e-01f, -2.902846773e-01f, -2.429801799e-01f, -1.950903220e-01f, -1.467304745e-01f, -9.801714033e-02f, -4.906767433e-02f, -1.836970199e-16f, 4.906767433e-02f, 9.801714033e-02f, 1.467304745e-01f, 1.950903220e-01f, 2.429801799e-01f, 2.902846773e-01f, 3.368898534e-01f, 3.826834324e-01f, 4.275550934e-01f, 4.713967368e-01f, 5.141027442e-01f, 5.555702330e-01f, 5.956993045e-01f, 6.343932842e-01f, 6.715589548e-01f, 7.071067812e-01f, 7.409511254e-01f, 7.730104534e-01f, 8.032075315e-01f, 8.314696123e-01f, 8.577286100e-01f, 8.819212643e-01f, 9.039892931e-01f, 9.238795325e-01f, 9.415440652e-01f, 9.569403357e-01f, 9.700312532e-01f, 9.807852804e-01f, 9.891765100e-01f, 9.951847267e-01f, 9.987954562e-01f,
    0.000000000e+00f, 4.906767433e-02f, 9.801714033e-02f, 1.467304745e-01f, 1.950903220e-01f, 2.429801799e-01f, 2.902846773e-01f, 3.368898534e-01f, 3.826834324e-01f, 4.275550934e-01f, 4.713967368e-01f, 5.141027442e-01f, 5.555702330e-01f, 5.956993045e-01f, 6.343932842e-01f, 6.715589548e-01f, 7.071067812e-01f, 7.409511254e-01f, 7.730104534e-01f, 8.032075315e-01f, 8.314696123e-01f, 8.577286100e-01f, 8.819212643e-01f, 9.039892931e-01f, 9.238795325e-01f, 9.415440652e-01f, 9.569403357e-01f, 9.700312532e-01f, 9.807852804e-01f, 9.891765100e-01f, 9.951847267e-01f, 9.987954562e-01f, 1.000000000e+00f, 9.987954562e-01f, 9.951847267e-01f, 9.891765100e-01f, 9.807852804e-01f, 9.700312532e-01f, 9.569403357e-01f, 9.415440652e-01f, 9.238795325e-01f, 9.039892931e-01f, 8.819212643e-01f, 8.577286100e-01f, 8.314696123e-01f, 8.032075315e-01f, 7.730104534e-01f, 7.409511254e-01f, 7.071067812e-01f, 6.715589548e-01f, 6.343932842e-01f, 5.956993045e-01f, 5.555702330e-01f, 5.141027442e-01f, 4.713967368e-01f, 4.275550934e-01f, 3.826834324e-01f, 3.368898534e-01f, 2.902846773e-01f, 2.429801799e-01f, 1.950903220e-01f, 1.467304745e-01f, 9.801714033e-02f, 4.906767433e-02f, 1.224646799e-16f, -4.906767433e-02f, -9.801714033e-02f, -1.467304745e-01f, -1.950903220e-01f, -2.429801799e-01f, -2.902846773e-01f, -3.368898534e-01f, -3.826834324e-01f, -4.275550934e-01f, -4.713967368e-01f, -5.141027442e-01f, -5.555702330e-01f, -5.956993045e-01f, -6.343932842e-01f, -6.715589548e-01f, -7.071067812e-01f, -7.409511254e-01f, -7.730104534e-01f, -8.032075315e-01f, -8.314696123e-01f, -8.577286100e-01f, -8.819212643e-01f, -9.039892931e-01f, -9.238795325e-01f, -9.415440652e-01f, -9.569403357e-01f, -9.700312532e-01f, -9.807852804e-01f, -9.891765100e-01f, -9.951847267e-01f, -9.987954562e-01f, -1.000000000e+00f, -9.987954562e-01f, -9.951847267e-01f, -9.891765100e-01f, -9.807852804e-01f, -9.700312532e-01f, -9.569403357e-01f, -9.415440652e-01f, -9.238795325e-01f, -9.039892931e-01f, -8.819212643e-01f, -8.577286100e-01f, -8.314696123e-01f, -8.032075315e-01f, -7.730104534e-01f, -7.409511254e-01f, -7.071067812e-01f, -6.715589548e-01f, -6.343932842e-01f, -5.956993045e-01f, -5.555702330e-01f, -5.141027442e-01f, -4.713967368e-01f, -4.275550934e-01f, -3.826834324e-01f, -3.368898534e-01f, -2.902846773e-01f, -2.429801799e-01f, -1.950903220e-01f, -1.467304745e-01f, -9.801714033e-02f, -4.906767433e-02f };
__device__ __forceinline__ void p0_prologue(Frame& F) {
    LAS float* sc = (LAS float*)(F.lds);
    LAS float* red = (LAS float*)(F.lds + 36864);
    for (int idx = F.tid; idx < 9 * 1024; idx += NWAVES * 64) { const int r = idx >> 10, k = idx & 1023; const float v = (r < 8) ? F.c[r * 1024 + k] : F.c_ctx[k]; sc[idx] = v * sigm(v); }
    __syncthreads();
    for (int item = F.vcu; item < NMOD / 32; item += F.G) {
        const int n0 = item * 32, kh = F.lane >> 5, nl = F.lane & 31;
        float acc[9];
#pragma unroll
        for (int r = 0; r < 9; ++r) acc[r] = 0.f;
#pragma unroll 1
        for (int i0 = 0; i0 < 64; i0 += 32) { float wv[32];
#pragma unroll
            for (int i = 0; i < 32; ++i) wv[i] = F.w_mod[(size_t)(F.wave * 128 + 2 * (i0 + i) + kh) * NMOD + n0 + nl];
#pragma unroll
            for (int i = 0; i < 32; ++i) { const int k = F.wave * 128 + 2 * (i0 + i) + kh;
#pragma unroll
                for (int r = 0; r < 9; ++r) acc[r] += sc[r * 1024 + k] * wv[i]; } }
#pragma unroll
        for (int r = 0; r < 9; ++r) acc[r] += __shfl_xor(acc[r], 32);
        if (F.lane < 32) {
#pragma unroll
            for (int r = 0; r < 9; ++r) red[(F.wave * 9 + r) * 32 + nl] = acc[r]; }
        __syncthreads();
        if (F.tid < 288) { const int r = F.tid >> 5, n = F.tid & 31; float s = F.b_mod[n0 + n];
#pragma unroll
            for (int w = 0; w < 8; ++w) s += red[(w * 9 + r) * 32 + n];
            F.MODF[r * NMOD + n0 + n] = s; }
        __syncthreads();
    }
    LAS float* scr = (LAS float*)(F.lds + 53248 + F.wave * 8704);
    const int gw = F.vcu * NWAVES + F.wave, NGW = F.G * NWAVES;
    constexpr int I_IN1 = 16 * 64, I_IN2 = 16 * 64, I_W1 = 16 * 128, I_W2 = 64 * 32, I_WO = 16 * 32, I_WLR = 16 * 32, I_WF = 8 * 32, I_G = 16 * 8;
    constexpr int I_PQ = 4 * 2 * 32 * 16, I_POS = 96, I_DFT = 2048;
    constexpr int NITEMS = I_IN1 + I_IN2 + I_W1 + I_W2 + I_WO + I_WLR + I_WF + 2 * I_G + I_PQ + I_POS + I_DFT;
    for (int it = gw; it < NITEMS; it += NGW) {
        int r = it;
        if (r < I_IN1) { p0_transpose_item(F.w_in, 1024, 4608, 0, 64, F.WIN, 0, scr, r, F.lane); continue; } r -= I_IN1;
        if (r < I_IN2) { p0_transpose_item(F.w_in, 1024, 4608, 2560, 64, F.WIN, 2048, scr, r, F.lane); continue; } r -= I_IN2;
        if (r < I_W1) { p0_transpose_item(F.w1, 1024, 4096, 0, 128, F.W1T, 0, scr, r, F.lane); continue; } r -= I_W1;
        if (r < I_W2) { p0_transpose_item(F.w2, 4096, 1024, 0, 32, F.W2T, 0, scr, r, F.lane); continue; } r -= I_W2;
        if (r < I_WO) { p0_transpose_item(F.w_out, 1024, 1024, 0, 32, F.WOUT, 0, scr, r, F.lane); continue; } r -= I_WO;
        if (r < I_WLR) { p0_transpose_item(F.w_lru_out, 1024, 1024, 0, 32, F.WL, 0, scr, r, F.lane); continue; } r -= I_WLR;
        if (r < I_WF) { p0_transpose_item(F.w_f_out, 512, 1024, 0, 32, F.WF, 0, scr, r, F.lane); continue; } r -= I_WF;
        if (r < I_G) { const int mat = r >> 3;
            p0_transpose_item(F.w_a + (size_t)mat * 16384, 128, 128, 0, 4, F.WG, mat * 256, scr, r & 7, F.lane); continue; } r -= I_G;
        if (r < I_G) { const int mat = r >> 3;
            p0_transpose_item(F.w_x + (size_t)mat * 16384, 128, 128, 0, 4, F.WG, mat * 256 + 128, scr, r & 7, F.lane); continue; } r -= I_G;
        if (r < I_PQ) {
            const int kc = r & 15, mc = (r >> 4) & 31, pq = (r >> 9) & 1, g = r >> 10;
            const int k = kc * 64 + F.lane, m0 = mc * 4;
            const float* wrow = F.w_in + (size_t)k * 4608 + 2048 + g * 128;
            const float* tg = c_trig128 + pq * 128;
            float acc[4] = {0.f, 0.f, 0.f, 0.f};
#pragma unroll 4
            for (int c4 = 0; c4 < 32; ++c4) { const f32x4 w4 = *(const f32x4*)(wrow + 4 * c4);
#pragma unroll
                for (int cc = 0; cc < 4; ++cc) { const int c = 4 * c4 + cc;
#pragma unroll
                    for (int mm = 0; mm < 4; ++mm) acc[mm] += tg[((m0 + mm) * c) & 127] * w4[cc]; } }
#pragma unroll
            for (int mm = 0; mm < 4; ++mm) F.WIN[(size_t)(4096 + pq * 512 + g * 128 + m0 + mm) * 1024 + k] = (bf16)f2bf(acc[mm] * (1.0f / 512.0f));
            continue; } r -= I_PQ;
        if (r < I_POS) {
            const float p = (float)(r < 32 ? r : r - 32);
#pragma unroll
            for (int j = 0; j < 8; ++j) { const int ch = j * 64 + F.lane, i = ch & 255;
                const float freq = expf(-9.210340371976184f * (float)i / 256.0f); const float ang = p * freq;
                float s, c; sincospif(ang * 0.3183098861837907f, &s, &c);
                F.POS[r * 512 + ch] = (ch < 256) ? s : c; }
            continue; } r -= I_POS;
        {
            const int k = r;
#pragma unroll 1
            for (int q = 0; q < 8; ++q) { const int col0 = (q * 64 + F.lane) * 8; float v[8];
#pragma unroll
                for (int j = 0; j < 8; ++j) { const int col = col0 + j, t = col & 2047; const int ph = (k * t) & 2047; float s, c; sincospif((float)ph * (1.0f / 1024.0f), &s, &c); v[j] = (col < 2048) ? c : -s; }
                v4u o; o.x = pk2(v[0], v[1]); o.y = pk2(v[2], v[3]); o.z = pk2(v[4], v[5]); o.w = pk2(v[6], v[7]);
                *(v4u*)(F.DFTM + (size_t)k * 4096 + col0) = o; }
        }
    }
}

template <int MODE> __device__ __forceinline__ void norm_rows(Frame& F) {
    const int gw = F.vcu * NWAVES + F.wave, NGW = F.G * NWAVES;
    const int nrows = (MODE == 0) ? (M + MC) : M;
    const float* gvec = (MODE == 0) ? F.g_mix : (MODE == 1 ? F.g_mlp : F.g_final);
    f32x4 g[4];
#pragma unroll
    for (int j = 0; j < 4; ++j) g[j] = *(const f32x4*)(gvec + 256 * j + 4 * F.lane);
    f32x4 vn[4];
    {   const int row = gw < nrows ? gw : 0; const bool lat = row < M;
        const float* src = (MODE == 0) ? (lat ? F.x + (size_t)row * D : F.ctx + (size_t)(row - M) * D) : F.out + (size_t)row * D;
#pragma unroll
        for (int j = 0; j < 4; ++j) vn[j] = *(const f32x4*)(src + 256 * j + 4 * F.lane); }
    for (int row = gw; row < nrows; row += NGW) {
        const bool lat = row < M;
        f32x4 v[4]; float ss = 0.f;
#pragma unroll
        for (int j = 0; j < 4; ++j) v[j] = vn[j];
        {   const int rn = (row + NGW < nrows) ? row + NGW : row; const bool latn = rn < M;
            const float* srcn = (MODE == 0) ? (latn ? F.x + (size_t)rn * D : F.ctx + (size_t)(rn - M) * D) : F.out + (size_t)rn * D;
#pragma unroll
            for (int j = 0; j < 4; ++j) vn[j] = *(const f32x4*)(srcn + 256 * j + 4 * F.lane); }
        if (MODE == 0 && lat) { const int t = row & (T - 1);
#pragma unroll
            for (int j = 0; j < 4; ++j) { const int c = 256 * j + 4 * F.lane;
                const f32x4 pv = (j < 2) ? *(const f32x4*)(F.POS + (t >> 6) * 512 + c) : *(const f32x4*)(F.POS + 32 * 512 + (t & 63) * 512 + (c - 512));
                v[j] = v[j] + pv; } }
#pragma unroll
        for (int j = 0; j < 4; ++j) ss += (v[j].x * v[j].x + v[j].y * v[j].y) + (v[j].z * v[j].z + v[j].w * v[j].w);
        const float rstd = 1.0f / sqrtf(wave_sum(ss) * (1.0f / D) + EPS);
        if (MODE == 2) {
#pragma unroll
            for (int j = 0; j < 4; ++j) *(f32x4*)(F.out + (size_t)row * D + 256 * j + 4 * F.lane) = v[j] * rstd * g[j];
        } else {
            const int mrow = lat ? (row >> 11) : 8;
            const float* mod = F.MODF + (size_t)mrow * NMOD + (MODE == 0 ? 0 : 3072);
            bf16* dst = (MODE == 0) ? (lat ? F.HLAT + (size_t)row * D : F.HCTX + (size_t)(row - M) * D) : F.UY + (size_t)row * D;
#pragma unroll
            for (int j = 0; j < 4; ++j) { const int c = 256 * j + 4 * F.lane;
                const f32x4 sh = *(const f32x4*)(mod + c), scl = *(const f32x4*)(mod + 1024 + c);
                const f32x4 h = v[j] * rstd * g[j] * (scl + 1.0f) + sh;
                v2u o; o.x = pk2(h.x, h.y); o.y = pk2(h.z, h.w);
                *(v2u*)(dst + c) = o; }
        }
    }
}

__device__ __forceinline__ void conv_phase(Frame& F) {
    const int gw = F.vcu * NWAVES + F.wave, NGW = F.G * NWAVES, lane = F.lane;
    for (int it = gw; it < 4608; it += NGW) {
        const bool lat = it < 4096; const int r = lat ? it : it - 4096;
        const int half = r & 1, row0 = (r >> 1) * 8;
        const int Tseg = lat ? T : CT; const int t0 = row0 & (Tseg - 1);
        const int c0 = half * 512 + lane * 8;
        const bf16* src = (lat ? F.UX : F.UXC) + (size_t)(row0 - t0) * D + c0;
        bf16* dst = (lat ? F.XC : F.XCC) + (size_t)(row0 - t0) * D + c0;
        v4u v[11];
#pragma unroll
        for (int i = 0; i < 11; ++i) { const int tt = t0 - 2 + i; v[i] = (tt >= 0 && tt < Tseg) ? *(const v4u*)(src + (size_t)tt * D) : (v4u){0u, 0u, 0u, 0u}; }
        f32x4 cw[4][2], cb[2];
#pragma unroll
        for (int k = 0; k < 4; ++k) { cw[k][0] = *(const f32x4*)(F.conv_w + k * 1024 + c0); cw[k][1] = *(const f32x4*)(F.conv_w + k * 1024 + c0 + 4); }
        cb[0] = *(const f32x4*)(F.conv_b + c0); cb[1] = *(const f32x4*)(F.conv_b + c0 + 4);
#pragma unroll
        for (int o = 0; o < 8; ++o) { f32x4 x0 = cb[0], x1 = cb[1];
#pragma unroll
            for (int k = 0; k < 4; ++k) { const v4u u = v[o + k];
                x0[0] += cw[k][0][0] * bflo(u.x); x0[1] += cw[k][0][1] * bfhi(u.x); x0[2] += cw[k][0][2] * bflo(u.y); x0[3] += cw[k][0][3] * bfhi(u.y);
                x1[0] += cw[k][1][0] * bflo(u.z); x1[1] += cw[k][1][1] * bfhi(u.z); x1[2] += cw[k][1][2] * bflo(u.w); x1[3] += cw[k][1][3] * bfhi(u.w); }
            *(v4u*)(dst + (size_t)(t0 + o) * D) = pg8::pack8(x0, x1); }
    }
}

constexpr int SC_W = 0;
constexpr int SC_TAB = 2 * 64 * 272;
template <int DIR>
__device__ __forceinline__ void scan_pass(Frame& F, int b, int hd, int q, float& carry, int& round, bf16* ya_dst) {
    const int lane = F.lane, w = F.wave, h = lane >> 5, cl = lane & 31;
    const LAS unsigned char* wl = F.lds + SC_W + DIR * (64 * 272);
    LAS float* tab = (LAS float*)(F.lds + SC_TAB);
    const int ch = hd * 128 + q * 32 + cl;
    constexpr float L2E = 1.4426950408889634f;
    const float cr = -F.b_a[DIR * 1024 + ch] * L2E, ci = -F.b_x[DIR * 1024 + ch] * L2E;
    const float nsp8 = -8.0f * log1pf(expf(-F.lam[DIR * 1024 + ch]));
    const float nsp8l = nsp8 * L2E;
    bf16x8 I0, I1;
#pragma unroll
    for (int j = 0; j < 8; ++j) { I0[j] = (8 * h + j == cl) ? (short)0x3F80 : (short)0; I1[j] = (16 + 8 * h + j == cl) ? (short)0x3F80 : (short)0; }
    const bf16* xlat = F.XC + (size_t)b * T * D + hd * 128 + 8 * h + (size_t)cl * D;
    const bf16* xctx = F.XCC + (size_t)b * CT * D + hd * 128 + 8 * h + (size_t)cl * D;
#define SC_R0(R_) ((R_) == 0 ? 0 : ((DIR == 0) ? ((R_) - 1) : (4 - (R_))) * 512)
#define SC_PTR(R_, mt_) (((R_) == 0 ? xctx : xlat) + (size_t)(SC_R0(R_) + 64 * w + 32 * (mt_)) * D)
#define SC_LOADX(X_, R_, mt_) do { const bf16* p_ = SC_PTR(R_, mt_); _Pragma("unroll") for (int ks_ = 0; ks_ < 8; ++ks_) X_[ks_] = *(const bf16x8*)(p_ + ks_ * 16); } while (0)
    bf16x8 X0[8], X1[8];
    const int firstR = (w < 4) ? 0 : 1;
    SC_LOADX(X0, firstR, 0);
#pragma unroll 1
    for (int R = 0; R < 5; ++R) {
        const int r0 = SC_R0(R);
        const int nact = (R == 0) ? 4 : 8;
        const bool active = w < nact;
        const int t0 = r0 + 64 * w;
        float av[2][16], bv[2][16];
        float preA[8], preH[8];
        bf16x8 Yh[2][2], Yu[2][2];
#define SC_LOADY(mt_) do { _Pragma("unroll") for (int s_ = 0; s_ < 2; ++s_) { const size_t o_ = ((size_t)b * T + t0 + 32 * (mt_) + cl) * D + hd * 128 + q * 32 + 16 * s_ + 8 * h; \
            Yh[mt_][s_] = *(const bf16x8*)(F.HLAT + o_); Yu[mt_][s_] = *(const bf16x8*)(F.UY + o_); } } while (0)
        if (active) {
#pragma unroll
            for (int mt = 0; mt < 2; ++mt) {
                if (mt == 0) SC_LOADX(X1, R, 1); else { const int Rn = (R < 4) ? R + 1 : R; SC_LOADX(X0, Rn, 0); }
                f32x16 accr, acci, accx;
#pragma unroll
                for (int i = 0; i < 16; ++i) { accr[i] = 0.f; acci[i] = 0.f; accx[i] = 0.f; }
#pragma unroll
                for (int ks = 0; ks < 8; ++ks) { const bf16x8 af = (mt == 0) ? X0[ks] : X1[ks];
                    const bf16x8 br = *(const LAS bf16x8*)(wl + cl * 272 + (ks * 16 + 8 * h) * 2);
                    const bf16x8 bi = *(const LAS bf16x8*)(wl + (32 + cl) * 272 + (ks * 16 + 8 * h) * 2);
                    accr = __builtin_amdgcn_mfma_f32_32x32x16_bf16(af, br, accr, 0, 0, 0);
                    acci = __builtin_amdgcn_mfma_f32_32x32x16_bf16(af, bi, acci, 0, 0, 0); }
                __builtin_amdgcn_sched_barrier(0);
                {
                    bf16x8 fa, fb;
                    if (mt == 0) { fa = (q == 0) ? X0[0] : (q == 1) ? X0[2] : (q == 2) ? X0[4] : X0[6]; fb = (q == 0) ? X0[1] : (q == 1) ? X0[3] : (q == 2) ? X0[5] : X0[7]; }
                    else         { fa = (q == 0) ? X1[0] : (q == 1) ? X1[2] : (q == 2) ? X1[4] : X1[6]; fb = (q == 0) ? X1[1] : (q == 1) ? X1[3] : (q == 2) ? X1[5] : X1[7]; }
                    accx = __builtin_amdgcn_mfma_f32_32x32x16_bf16(fa, I0, accx, 0, 0, 0);
                    accx = __builtin_amdgcn_mfma_f32_32x32x16_bf16(fb, I1, accx, 0, 0, 0); }
                __builtin_amdgcn_sched_barrier(0);
#pragma unroll
                for (int reg = 0; reg < 16; ++reg) {
                    const float e1 = __builtin_amdgcn_exp2f(accr[reg] * (-L2E) + cr), e2 = __builtin_amdgcn_exp2f(acci[reg] * (-L2E) + ci);
                    const float rg = __builtin_amdgcn_rcpf(1.0f + e1), ig = __builtin_amdgcn_rcpf(1.0f + e2);
                    const float a = __builtin_amdgcn_exp2f(nsp8l * rg);
                    const float x2 = 2.0f * nsp8 * rg;
                    float pz = x2 * (1.0f / 24.0f) + (1.0f / 6.0f); pz = pz * x2 + 0.5f; pz = pz * x2 + 1.0f;
                    const float m2 = (x2 > -0.3f) ? (-x2 * pz) : (1.0f - a * a);
                    av[mt][reg] = a; bv[mt][reg] = __builtin_amdgcn_sqrtf(m2) * ig * accx[reg]; }
                __builtin_amdgcn_sched_barrier(0);
            }
            __builtin_amdgcn_sched_barrier(0);
            float gA[8], gH[8];
#pragma unroll
            for (int mt = 0; mt < 2; ++mt)
#pragma unroll
                for (int g4 = 0; g4 < 4; ++g4) { float ar = 1.f, hr = 0.f;
#pragma unroll
                    for (int ii = 0; ii < 4; ++ii) { const int i = g4 * 4 + (DIR == 0 ? ii : 3 - ii);
                        hr = av[mt][i] * hr + bv[mt][i]; ar = ar * av[mt][i]; av[mt][i] = ar; bv[mt][i] = hr; }
                    gA[mt * 4 + g4] = ar; gH[mt * 4 + g4] = hr; }
            float pA[8], pH[8];
#pragma unroll
            for (int gi = 0; gi < 8; ++gi) { pA[gi] = __shfl_xor(gA[gi], 32); pH[gi] = __shfl_xor(gH[gi], 32); }
            float Ar = 1.f, Hr = 0.f;
#pragma unroll
            for (int gg = 0; gg < 8; ++gg) { const int gi = (DIR == 0) ? gg : 7 - gg;
                const bool own_first = (DIR == 0) ? (h == 0) : (h == 1);
                const float fA = own_first ? gA[gi] : pA[gi], fH = own_first ? gH[gi] : pH[gi];
                const float sA = own_first ? pA[gi] : gA[gi], sH = own_first ? pH[gi] : gH[gi];
                const float Ar1 = fA * Ar, Hr1 = fA * Hr + fH;
                preA[gi] = own_first ? Ar : Ar1; preH[gi] = own_first ? Hr : Hr1;
                Ar = sA * Ar1; Hr = sA * Hr1 + sH; }
            __builtin_amdgcn_sched_barrier(0);
            if (DIR == 1 && R > 0) SC_LOADY(0);
            if (lane < 32) { tab[((round & 1) * 8 + w) * 64 + cl] = Ar; tab[((round & 1) * 8 + w) * 64 + 32 + cl] = Hr; }
        }
        __syncthreads();
        float my = carry; { float c = carry;
#pragma unroll
            for (int ww = 0; ww < 8; ++ww) { const int w2 = (DIR == 0) ? ww : 7 - ww;
                if (w2 < nact) { if (w2 == w) my = c; c = tab[((round & 1) * 8 + w2) * 64 + cl] * c + tab[((round & 1) * 8 + w2) * 64 + 32 + cl]; } }
            carry = c; }
        ++round;
        if (active && R > 0) {
            if (DIR == 1) SC_LOADY(1);
#pragma unroll
            for (int mt = 0; mt < 2; ++mt) {
                f32x16 hfC, gyC;
                if (DIR == 1) {
#pragma unroll
                    for (int i = 0; i < 16; ++i) { hfC[i] = 0.f; gyC[i] = 0.f; }
                    hfC = __builtin_amdgcn_mfma_f32_32x32x16_bf16(Yh[mt][0], I0, hfC, 0, 0, 0); hfC = __builtin_amdgcn_mfma_f32_32x32x16_bf16(Yh[mt][1], I1, hfC, 0, 0, 0);
                    gyC = __builtin_amdgcn_mfma_f32_32x32x16_bf16(Yu[mt][0], I0, gyC, 0, 0, 0); gyC = __builtin_amdgcn_mfma_f32_32x32x16_bf16(Yu[mt][1], I1, gyC, 0, 0, 0); }
#pragma unroll
                for (int reg = 0; reg < 16; ++reg) { const int gi = mt * 4 + (reg >> 2);
                    const float gc = preH[gi] + preA[gi] * my;
                    const float hv = bv[mt][reg] + av[mt][reg] * gc;
                    const int tok = t0 + 32 * mt + 8 * (reg >> 2) + 4 * h + (reg & 3);
                    const size_t idx = ((size_t)b * T + tok) * D + ch;
                    if (DIR == 0) F.HLAT[idx] = (bf16)(pg8::cvt_pk_bf16(hv, hv) & 0xffffu);
                    else { const float y = (hfC[reg] + hv) * gyC[reg]; ya_dst[idx] = (bf16)(pg8::cvt_pk_bf16(y, y) & 0xffffu); } }
            }
        }
    }
#undef SC_R0
#undef SC_PTR
#undef SC_LOADX
#undef SC_LOADY
}
__device__ __forceinline__ void scan_phase(Frame& F, bf16* ya_dst) {
    int round = 0;
    for (int item = F.vcu; item < NB * 8 * 4; item += F.G) {
        const int q = item & 3, hd = (item >> 2) & 7, b = item >> 5;
        for (int i = F.tid; i < 2048; i += NWAVES * 64) { const int ck = i & 15, row = (i >> 4) & 63, dir = i >> 10; const int g = row >> 5, e = row & 31;
            const v4u v = *(const v4u*)(F.WG + ((size_t)((dir * 8 + hd) * 256 + g * 128 + q * 32 + e)) * 128 + ck * 8);
            *(LAS v4u*)(F.lds + SC_W + dir * (64 * 272) + row * 272 + ck * 16) = v; }
        __syncthreads();
        float carry = 0.f;
        scan_pass<0>(F, b, hd, q, carry, round, ya_dst);
        VM_WAIT(); __syncthreads();
        carry = 0.f;
        scan_pass<1>(F, b, hd, q, carry, round, ya_dst);
        __syncthreads();
    }
}

struct Args { const float* in[22]; float* out; unsigned char* ws; int ph_lo, ph_hi; };
__global__ void __launch_bounds__(NWAVES * 64, 2) mk_fwd(Args args) {
    extern __shared__ __attribute__((aligned(16))) unsigned char lds[];
    Frame F;
    F.lds = (LAS unsigned char*)lds;
    F.MISC = (volatile LAS unsigned*)(F.lds + MISC_OFF);
    F.tid = threadIdx.x; F.lane = F.tid & 63; F.wave = __builtin_amdgcn_readfirstlane(F.tid >> 6);
    F.G = gridDim.x; { const int bx = blockIdx.x; F.vcu = (F.G % 8 == 0) ? (bx % 8) * (F.G / 8) + bx / 8 : bx; }
    unsigned char* ws = args.ws;
    F.ctl = (gu32*)(ws + WS_CTL);
    F.x = args.in[0]; F.c = args.in[1]; F.ctx = args.in[2]; F.c_ctx = args.in[3]; F.w_mod = args.in[4]; F.b_mod = args.in[5]; F.g_mix = args.in[6]; F.w_in = args.in[7];
    F.conv_w = args.in[8]; F.conv_b = args.in[9]; F.w_a = args.in[10]; F.b_a = args.in[11]; F.w_x = args.in[12]; F.b_x = args.in[13]; F.lam = args.in[14];
    F.w_lru_out = args.in[15]; F.w_f_out = args.in[16]; F.w_out = args.in[17]; F.g_mlp = args.in[18]; F.w1 = args.in[19]; F.w2 = args.in[20]; F.g_final = args.in[21];
    F.out = args.out;
    F.MODF = (float*)(ws + WS_MODF); F.POS = (float*)(ws + WS_POS);
    F.WIN = (bf16*)(ws + WS_WIN); F.W1T = (bf16*)(ws + WS_W1); F.W2T = (bf16*)(ws + WS_W2); F.WOUT = (bf16*)(ws + WS_WOUT); F.WL = (bf16*)(ws + WS_WL); F.WF = (bf16*)(ws + WS_WF); F.WG = (bf16*)(ws + WS_WG);
    F.HCTX = (bf16*)(ws + WS_HCTX); F.UXC = (bf16*)(ws + WS_UXC); F.HLAT = (bf16*)(ws + WS_HLAT); F.UX = (bf16*)(ws + WS_UX); F.PQT = (bf16*)(ws + WS_PQT); F.YF = (bf16*)(ws + WS_YF);
    F.DFTM = (bf16*)(ws + WS_DFTM); F.HID = (bf16*)(ws + WS_HID); F.UY = (bf16*)(ws + WS_UY); F.YB = (bf16*)(ws + WS_YB); F.UG = (bf16*)args.out; F.XC = F.YB; F.XCC = F.HCTX;
    for (int u = F.tid; u < (LDS_BYTES - LDSCTL_OFF) / 4; u += NWAVES * 64) ((LAS unsigned*)(F.lds + LDSCTL_OFF))[u] = 0u;
    __syncthreads();
    const bool one_launch = (args.ph_hi - args.ph_lo) > 1;
    XcdBarrier bar; bar.bar = (unsigned*)(F.ctl + CW_BAR); bar.x = 0; bar.st = nullptr;
    if (one_launch) bar = xcd_barrier_post((unsigned*)(F.ctl + CW_BAR), F.MISC + 8);
    const int lo = args.ph_lo, hi = args.ph_hi;
#ifdef ONLY_PH
#define IN(k) ((k) == ONLY_PH)
#else
#define IN(k) (lo <= (k) && (k) < hi)
#endif
#define SEAM(k) do { if (IN(k) && IN((k) + 1)) xcd_barrier(bar); } while (0)
    using pg8::Gemm; using pg8::StaticOrder;
    const int cid = (int)blockIdx.x;

#ifndef REP_PH
#define REP_PH -1
#define REP_N 1
#endif
#define REPS(k) ((k) == REP_PH ? REP_N : 1)
#define REPBAR(k) do { if (rep + 1 < REPS(k)) xcd_barrier(bar); } while (0)
    int ph = 0;
#define PHASE_BEGIN if (IN(ph)) { for (int rep = 0; rep < REPS(ph); ++rep) {
#define PHASE_END   REPBAR(ph); } SEAM(ph); } ++ph;
    PHASE_BEGIN p0_prologue(F); PHASE_END
    PHASE_BEGIN norm_rows<0>(F); PHASE_END
    PHASE_BEGIN
        { Gemm g{F.HLAT, F.WIN, M, 4096, D}; StaticOrder S; S.init(M, 4096, F.G, cid); pg8::EpiInMain E{F.UX, F.UY, F.UG};
          pg8::gemm_phase<pg8::EpiInMain, StaticOrder, true, true>(F.lds + RING_OFF, g, S, E); }
        { Gemm g{F.WIN + (size_t)4096 * D, F.HLAT, 1024, M, D}; StaticOrder S; S.init(1024, M, F.G, cid); pg8::EpiPQT E{F.PQT};
          pg8::gemm_phase<pg8::EpiPQT, StaticOrder, true, true>(F.lds + RING_OFF, g, S, E); }
        { Gemm g{F.HCTX, F.WIN, MC, 1024, D}; StaticOrder S; S.init(MC, 1024, F.G, cid); pg8::EpiBf16<0> E{F.UXC, D};
          pg8::gemm_phase<pg8::EpiBf16<0>, StaticOrder, true, true>(F.lds + RING_OFF, g, S, E); }
    PHASE_END
    PHASE_BEGIN conv_phase(F); PHASE_END
    PHASE_BEGIN scan_phase(F, rep + 1 < REPS(ph) ? F.UX : F.UY); PHASE_END
    PHASE_BEGIN
        Gemm g{F.DFTM, F.PQT, T, NB * FW, 2 * T}; StaticOrder S; S.init(T, NB * FW, F.G, cid); pg8::EpiDft E{F.YF};
        pg8::gemm_phase<pg8::EpiDft, StaticOrder, true, true>(F.lds + RING_OFF, g, S, E);
    PHASE_END
    PHASE_BEGIN
        Gemm g{F.YF, F.WF, M, D, FW}; StaticOrder S; S.init(M, D, F.G, cid); pg8::EpiGate<false> E{F.YB, D, F.UG + 1024, 2048, nullptr};
        pg8::gemm_phase<pg8::EpiGate<false>, StaticOrder, true, true>(F.lds + RING_OFF, g, S, E);
    PHASE_END
    PHASE_BEGIN
        Gemm g{F.UY, F.WL, M, D, D}; StaticOrder S; S.init(M, D, F.G, cid); pg8::EpiGate<true> E{F.UX, D, F.UG, 2048, F.YB};
        pg8::gemm_phase<pg8::EpiGate<true>, StaticOrder, true, true>(F.lds + RING_OFF, g, S, E);
    PHASE_END
    PHASE_BEGIN
        Gemm g{F.UX, F.WOUT, M, D, D}; StaticOrder S; S.init(M, D, F.G, cid); pg8::EpiResid<0> E{F.x, F.out, F.MODF + 2048, F.POS};
        pg8::gemm_phase<pg8::EpiResid<0>, StaticOrder, true, true>(F.lds + RING_OFF, g, S, E);
    PHASE_END
    PHASE_BEGIN norm_rows<1>(F); PHASE_END
    PHASE_BEGIN
        Gemm g{F.UY, F.W1T, M, FF, D}; StaticOrder S; S.init(M, FF, F.G, cid); pg8::EpiBf16<1> E{F.HID, FF};
        pg8::gemm_phase<pg8::EpiBf16<1>, StaticOrder, true, true>(F.lds + RING_OFF, g, S, E);
    PHASE_END
    PHASE_BEGIN
        Gemm g{F.HID, F.W2T, M, D, FF}; StaticOrder S; S.init(M, D, F.G, cid); pg8::EpiResid<1> E{nullptr, F.out, F.MODF + 5120, nullptr};
        pg8::gemm_phase<pg8::EpiResid<1>, StaticOrder, true, true>(F.lds + RING_OFF, g, S, E);
    PHASE_END
    PHASE_BEGIN norm_rows<2>(F); PHASE_END
#undef IN
#undef SEAM
}

extern "C" void kernel_launch(void* const* d_in, const int* in_sizes, int n_in, void* d_out, int out_size, void* d_ws, size_t ws_size, hipStream_t stream) {
    static int grid = 0;
    if (grid == 0) {
        if (n_in != 22 || in_sizes[0] != M * D || out_size != M * D || ws_size < WS_END) { fprintf(stderr, "kernel_launch: unexpected shapes (n_in %d, in0 %d, out %d, ws %zu); nothing launched\n", n_in, n_in > 0 ? in_sizes[0] : -1, out_size, ws_size); grid = -1; return; }
        int dev = 0, cus = 0, per_cu = 0;
        if (hipGetDevice(&dev) != hipSuccess || hipDeviceGetAttribute(&cus, hipDeviceAttributeMultiprocessorCount, dev) != hipSuccess) { fprintf(stderr, "kernel_launch: device query failed\n"); grid = -1; return; }
        if (hipFuncSetAttribute((const void*)mk_fwd, hipFuncAttributeMaxDynamicSharedMemorySize, LDS_BYTES) != hipSuccess) { fprintf(stderr, "kernel_launch: hipFuncSetAttribute failed\n"); grid = -1; return; }
        if (hipOccupancyMaxActiveBlocksPerMultiprocessor(&per_cu, (const void*)mk_fwd, NWAVES * 64, LDS_BYTES) != hipSuccess || per_cu < 1) { fprintf(stderr, "kernel_launch: occupancy query reports %d workgroups per CU\n", per_cu); (void)hipGetLastError(); grid = -1; return; }
        grid = cus;
    }
    if (grid < 0) return;
    if (hipMemsetAsync((char*)d_ws + WS_CTL, 0, CTL_ZERO_BYTES, stream) != hipSuccess) { fprintf(stderr, "kernel_launch: hipMemsetAsync failed\n"); return; }
    Args a{};
    for (int i = 0; i < 22; ++i) a.in[i] = (const float*)d_in[i];
    a.out = (float*)d_out; a.ws = (unsigned char*)d_ws;
    if (N_LAUNCHES == 1) {
        a.ph_lo = 0; a.ph_hi = N_PHASES;
        void* kargs[] = {&a};
        const hipError_t le = hipLaunchCooperativeKernel((const void*)mk_fwd, dim3(grid), dim3(NWAVES * 64), kargs, LDS_BYTES, stream);
        if (le != hipSuccess) fprintf(stderr, "kernel_launch: cooperative launch failed: %s (grid %d)\n", hipGetErrorName(le), grid);
    } else {
        for (int li = 0; li < N_PHASES; ++li) {
            a.ph_lo = li; a.ph_hi = li + 1;
            hipLaunchKernelGGL(mk_fwd, dim3(grid), dim3(NWAVES * 64), LDS_BYTES, stream, a);
            const hipError_t le = hipPeekAtLastError();
            if (le != hipSuccess) { fprintf(stderr, "kernel_launch: launch %d failed: %s\n", li, hipGetErrorName(le)); break; }
        }
    }
}
```

```cpp
#include <hip/hip_runtime.h>
#include <cstdio>
#include <cstdint>
#define MK_N_LAUNCHES 1
namespace pg8 {
#define PG8_LAS __attribute__((address_space(3)))
typedef unsigned short bf16_t;
typedef short bf16x8 __attribute__((ext_vector_type(8)));
typedef float f32x4 __attribute__((ext_vector_type(4)));
typedef unsigned u32x4 __attribute__((ext_vector_type(4)));
constexpr int BM = 256, BK = 64, HALF = 128, HTB = HALF * BK * 2  , STAGE_BYTES = 8 * HTB, NXCD = 8, WGM = 8;

__host__ __device__ __forceinline__ int lds_byte(int r, int c) { const int st = (r >> 4) * 2 + (c >> 5), rr = r & 15, cc = c & 31, ob = rr * 64 + cc * 2; return st * 1024 + (ob ^ (((ob >> 9) & 1) << 5)); }
__host__ __device__ __forceinline__ void stage_rc(int b, int& R, int& C) { const int st = b / 1024, sb = b % 1024, swz = sb ^ (((sb >> 9) & 1) << 5); R = (st >> 1) * 16 + swz / 64; C = (st & 1) * 32 + (swz % 64) / 2; }
__host__ __device__ __forceinline__ int perm32(int rho) { const int n = rho >> 4, i = rho & 15; return 8 * (i >> 2) + 4 * n + (i & 3); }

struct Unit { int pm, pn; };
struct Gemm { const bf16_t* A; const bf16_t* Bt; int M, N, K; };

struct StaticOrder {
    int nM, nN, nwg, G, c;
    __host__ __device__ void init(int M, int N, int G_, int c_) { nM = M / BM; nN = N / BM; nwg = nM * nN; G = G_; c = c_; }
    __host__ __device__ bool next(int i, Unit& u) const {
        const long L = (long)i * G + c; if (L >= nwg) return false;
        int wgid = (int)L; { const int q = nwg / NXCD, r = nwg % NXCD, xcd = wgid % NXCD, off = wgid / NXCD; wgid = (xcd < r ? xcd * (q + 1) : r * (q + 1) + (xcd - r) * q) + off; }
        const int nig = WGM * nN, gid = wgid / nig, fm = gid * WGM, gsz = (nM - fm) < WGM ? (nM - fm) : WGM;
        u.pm = fm + ((wgid % nig) % gsz); u.pn = (wgid % nig) / gsz; return true;
    }
    __device__ __forceinline__ void a_ready(const Unit&) const {}
    __device__ __forceinline__ void done(const Unit&) const {}
};

__device__ __forceinline__ unsigned cvt_pk_bf16(float lo, float hi) { unsigned r; asm volatile("v_cvt_pk_bf16_f32 %0, %1, %2" : "=v"(r) : "v"(lo), "v"(hi)); return r; }
__device__ __forceinline__ float bf_lo(unsigned w) { return __uint_as_float(w << 16); }
__device__ __forceinline__ float bf_hi(unsigned w) { return __uint_as_float(w & 0xffff0000u); }
__device__ __forceinline__ float sigm(float x) { return __builtin_amdgcn_rcpf(1.0f + __expf(-x)); }
__device__ __forceinline__ float gelu_tanh(float x) { const float z = 1.5957691216f * (x + 0.044715f * x * x * x); return x * sigm(z); }
__device__ __forceinline__ u32x4 pack8(const f32x4 v0, const f32x4 v1) { u32x4 w; w.x = cvt_pk_bf16(v0[0], v0[1]); w.y = cvt_pk_bf16(v0[2], v0[3]); w.z = cvt_pk_bf16(v1[0], v1[1]); w.w = cvt_pk_bf16(v1[2], v1[3]); return w; }

struct EpiInMain {
    static constexpr bool PERM = true, AFTER_DRAIN = false;
    bf16_t* UX; bf16_t* UY; bf16_t* UG; bf16_t* PQ;
    __device__ __forceinline__ void operator()(const f32x4 (&acc)[2][2][4][2], const Unit& u, int wr, int wc, int fr, int fq) const {
        const int row0 = u.pm * BM + wr * 64 + fr; const int ct = u.pn * BM;
        bf16_t* base; int ldc, colt, act;
        if (ct < 1024) { base = UX; ldc = 1024; colt = ct; act = 0; }
        else if (ct < 2048) { base = UY; ldc = 1024; colt = ct - 1024; act = 1; }
        else if (ct < 4096) { base = UG; ldc = 2048; colt = ct - 2048; act = 2; }
        else { base = PQ; ldc = 1024; colt = ct - 4096; act = 0; }
        const int col0 = colt + wc * 32 + 8 * fq;
#pragma unroll
        for (int ai = 0; ai < 2; ++ai)
#pragma unroll
            for (int m = 0; m < 4; ++m) { bf16_t* rowp = base + (size_t)(row0 + ai * HALF + m * 16) * ldc + col0;
#pragma unroll
                for (int bj = 0; bj < 2; ++bj) { f32x4 v0 = acc[ai][bj][m][0], v1 = acc[ai][bj][m][1];
                    if (act == 1) {
#pragma unroll
                        for (int j = 0; j < 4; ++j) { v0[j] = gelu_tanh(v0[j]); v1[j] = gelu_tanh(v1[j]); } }
                    if (act == 2) {
#pragma unroll
                        for (int j = 0; j < 4; ++j) { v0[j] = sigm(v0[j]); v1[j] = sigm(v1[j]); } }
                    *(u32x4*)(rowp + bj * HALF) = pack8(v0, v1); } }
    }
};
template <int ACT  > struct EpiBf16 {
    static constexpr bool PERM = true, AFTER_DRAIN = false;
    bf16_t* O; int ldc;
    __device__ __forceinline__ void operator()(const f32x4 (&acc)[2][2][4][2], const Unit& u, int wr, int wc, int fr, int fq) const {
        const int row0 = u.pm * BM + wr * 64 + fr; const int col0 = u.pn * BM + wc * 32 + 8 * fq;
#pragma unroll
        for (int ai = 0; ai < 2; ++ai)
#pragma unroll
            for (int m = 0; m < 4; ++m) { bf16_t* rowp = O + (size_t)(row0 + ai * HALF + m * 16) * ldc + col0;
#pragma unroll
                for (int bj = 0; bj < 2; ++bj) { f32x4 v0 = acc[ai][bj][m][0], v1 = acc[ai][bj][m][1];
                    if (ACT == 1) {
#pragma unroll
                        for (int j = 0; j < 4; ++j) { const float a = fmaxf(v0[j], 0.f), b = fmaxf(v1[j], 0.f); v0[j] = a * a; v1[j] = b * b; } }
                    *(u32x4*)(rowp + bj * HALF) = pack8(v0, v1); } }
    }
};
struct EpiPQT {
    static constexpr bool PERM = true, AFTER_DRAIN = false;
    bf16_t* PQT;
    __device__ __forceinline__ void operator()(const f32x4 (&acc)[2][2][4][2], const Unit& u, int wr, int wc, int fr, int fq) const {
        const int row0 = u.pm * BM + wr * 64 + fr; const int col0 = u.pn * BM + wc * 32 + 8 * fq;
#pragma unroll
        for (int ai = 0; ai < 2; ++ai)
#pragma unroll
            for (int m = 0; m < 4; ++m) { const int row = row0 + ai * HALF + m * 16; const int pq = row >> 9, j = row & 511;
#pragma unroll
                for (int bj = 0; bj < 2; ++bj) { const int col = col0 + bj * HALF; const int b = col >> 11, t = col & 2047;
                    bf16_t* p = PQT + (((size_t)(b * 512 + j) * 2 + pq) * 2048 + t);
                    *(u32x4*)p = pack8(acc[ai][bj][m][0], acc[ai][bj][m][1]); } }
    }
};
struct EpiDft {
    static constexpr bool PERM = true, AFTER_DRAIN = false;
    bf16_t* YF;
    __device__ __forceinline__ void operator()(const f32x4 (&acc)[2][2][4][2], const Unit& u, int wr, int wc, int fr, int fq) const {
        const int row0 = u.pm * BM + wr * 64 + fr; const int col0 = u.pn * BM + wc * 32 + 8 * fq;
#pragma unroll
        for (int ai = 0; ai < 2; ++ai)
#pragma unroll
            for (int m = 0; m < 4; ++m) { const int k = row0 + ai * HALF + m * 16;
#pragma unroll
                for (int bj = 0; bj < 2; ++bj) { const int col = col0 + bj * HALF; const int b = col >> 9, j = col & 511;
                    bf16_t* p = YF + ((size_t)(b * 2048 + k) * 512 + j);
                    *(u32x4*)p = pack8(acc[ai][bj][m][0], acc[ai][bj][m][1]); } }
    }
};
template <bool HAS_ADD> struct EpiGate {
    static constexpr bool PERM = true, AFTER_DRAIN = false;
    bf16_t* O; int ldc; const bf16_t* G; int ldg; const bf16_t* ADD;
    __device__ __forceinline__ void operator()(const f32x4 (&acc)[2][2][4][2], const Unit& u, int wr, int wc, int fr, int fq) const {
        const int row0 = u.pm * BM + wr * 64 + fr; const int col0 = u.pn * BM + wc * 32 + 8 * fq;
#pragma unroll
        for (int ai = 0; ai < 2; ++ai)
#pragma unroll
            for (int m = 0; m < 4; ++m) { const size_t row = (size_t)(row0 + ai * HALF + m * 16);
#pragma unroll
                for (int bj = 0; bj < 2; ++bj) { const int col = col0 + bj * HALF;
                    const u32x4 g = *(const u32x4*)(G + row * ldg + col);
                    f32x4 v0 = acc[ai][bj][m][0], v1 = acc[ai][bj][m][1];
                    v0[0] *= bf_lo(g.x); v0[1] *= bf_hi(g.x); v0[2] *= bf_lo(g.y); v0[3] *= bf_hi(g.y);
                    v1[0] *= bf_lo(g.z); v1[1] *= bf_hi(g.z); v1[2] *= bf_lo(g.w); v1[3] *= bf_hi(g.w);
                    if (HAS_ADD) { const u32x4 a = *(const u32x4*)(ADD + row * ldc + col);
                        v0[0] += bf_lo(a.x); v0[1] += bf_hi(a.x); v0[2] += bf_lo(a.y); v0[3] += bf_hi(a.y);
                        v1[0] += bf_lo(a.z); v1[1] += bf_hi(a.z); v1[2] += bf_lo(a.w); v1[3] += bf_hi(a.w); }
                    *(u32x4*)(O + row * ldc + col) = pack8(v0, v1); } }
    }
};
template <int MODE> struct EpiResid {
    static constexpr bool PERM = false, AFTER_DRAIN = false;
    const float* X; float* O; const float* gate  ; const float* pos  ;
    __device__ __forceinline__ void operator()(const f32x4 (&acc)[2][2][4][2], const Unit& u, int wr, int wc, int fr, int fq) const {
        const int row0 = u.pm * BM + wr * 64 + fr, col0 = u.pn * BM + wc * 32 + 4 * fq;
#pragma unroll
        for (int ai = 0; ai < 2; ++ai)
#pragma unroll
            for (int m = 0; m < 4; ++m) { const int row = row0 + ai * HALF + m * 16; const int b = row >> 11, t = row & 2047;
#pragma unroll
                for (int bj = 0; bj < 2; ++bj)
#pragma unroll
                    for (int n = 0; n < 2; ++n) { const int c = col0 + bj * HALF + n * 16;
                        const f32x4 gt = *(const f32x4*)(gate + (size_t)b * 6144 + c);
                        f32x4 base;
                        if (MODE == 0) { const f32x4 pv = (c < 512) ? *(const f32x4*)(pos + (t >> 6) * 512 + c) : *(const f32x4*)(pos + 32 * 512 + (t & 63) * 512 + (c - 512));
                            base = *(const f32x4*)(X + (size_t)row * 1024 + c) + pv; }
                        else base = *(const f32x4*)(O + (size_t)row * 1024 + c);
                        *(f32x4*)(O + (size_t)row * 1024 + c) = base + gt * acc[ai][bj][m][n]; }
                asm volatile("" ::: "memory"); }
    }
};

template <class Epi, class Sched, bool ALIGN_EPI = false, bool SP2 = false>
__device__ __forceinline__ void gemm_phase(PG8_LAS unsigned char* lds, const Gemm g, const Sched& S, const Epi& E) {
    const int tid = threadIdx.x, wid = __builtin_amdgcn_readfirstlane(tid >> 6), lane = tid & 63, wr = wid >> 2, wc = wid & 3, fr = lane & 15, fq = lane >> 4;
    const int K = g.K, nt = K / BK;
    unsigned voffA[2], voffB[2];
#pragma unroll
    for (int i = 0; i < 2; ++i) { int R, C; stage_rc(tid * 16 + i * 8192, R, C); const int Rb = Epi::PERM ? ((R & ~31) + perm32(R & 31)) : R;
        voffA[i] = (unsigned)(R * K + C) * 2u; voffB[i] = (unsigned)(Rb * K + C) * 2u; }
    const size_t kstep = (size_t)(BK * 2);
    const size_t hstep = (size_t)HALF * K * 2;
    const size_t tstep = 2 * hstep;
    const unsigned ldsw = (unsigned)wid * 1024u;
    const int aoff = lds_byte(wr * 64 + fr, fq * 8), boff = lds_byte(wc * 32 + fr, fq * 8);
#define PG8_SA(b, h) (((b) * 2 + (h)) * HTB)
#define PG8_SB(b, h) ((4 + (b) * 2 + (h)) * HTB)
#define PG8_STAGE(bufoff, gbase, voff) do { _Pragma("unroll") for (int _i = 0; _i < 2; ++_i) \
        __builtin_amdgcn_global_load_lds((const unsigned*)((const char*)(gbase) + (voff)[_i]), (PG8_LAS unsigned*)(lds + (bufoff) + ldsw + _i * 8192), 16, 0, 0); } while (0)
#define PG8_LDA(dst, b, h) do { _Pragma("unroll") for (int m = 0; m < 4; ++m) _Pragma("unroll") for (int k = 0; k < 2; ++k) dst[m][k] = *(const PG8_LAS bf16x8*)(lds + PG8_SA(b, h) + aoff + m * 2048 + k * 1024); } while (0)
#define PG8_LDB(dst, b, h) do { _Pragma("unroll") for (int n = 0; n < 2; ++n) _Pragma("unroll") for (int k = 0; k < 2; ++k) dst[n][k] = *(const PG8_LAS bf16x8*)(lds + PG8_SB(b, h) + boff + n * 2048 + k * 1024); } while (0)
#define PG8_MMA(ai, bj, At, Bt) do { __builtin_amdgcn_s_setprio(1); _Pragma("unroll") for (int m = 0; m < 4; ++m) _Pragma("unroll") for (int n = 0; n < 2; ++n) _Pragma("unroll") for (int k = 0; k < 2; ++k) \
        acc[ai][bj][m][n] = __builtin_amdgcn_mfma_f32_16x16x32_bf16(Bt[n][k], At[m][k], acc[ai][bj][m][n], 0, 0, 0); __builtin_amdgcn_s_setprio(0); } while (0)
#define PG8_WAIT_V(n) asm volatile("s_waitcnt vmcnt(" #n ")" ::: "memory")
#define PG8_WAIT_L(n) asm volatile("s_waitcnt lgkmcnt(" #n ")" ::: "memory")
#define PG8_BAR __builtin_amdgcn_s_barrier()
#define PG8_SCHED __builtin_amdgcn_sched_barrier(0)
    Unit cur, nxt; int ui = 0;
    if (!S.next(0, cur)) return;
    f32x4 acc[2][2][4][2];
#pragma unroll
    for (int a = 0; a < 2; ++a)
#pragma unroll
        for (int b = 0; b < 2; ++b)
#pragma unroll
            for (int m = 0; m < 4; ++m)
#pragma unroll
                for (int n = 0; n < 2; ++n) acc[a][b][m][n] = (f32x4){0.f, 0.f, 0.f, 0.f};
    bf16x8 At[4][2], B0[2][2], B1[2][2];
    const char* cA = (const char*)g.A + (size_t)cur.pm * tstep; const char* cB = (const char*)g.Bt + (size_t)cur.pn * tstep;
    S.a_ready(cur);
    if constexpr (SP2) {
        PG8_STAGE(PG8_SB(0, 0), cB, voffB); PG8_STAGE(PG8_SB(0, 1), cB + hstep, voffB); PG8_STAGE(PG8_SA(0, 0), cA, voffA); PG8_STAGE(PG8_SA(0, 1), cA + hstep, voffA);
        if (wr == 1) PG8_BAR;
        PG8_WAIT_V(2); PG8_BAR;
        PG8_STAGE(PG8_SB(1, 0), cB + kstep, voffB); PG8_STAGE(PG8_SA(1, 0), cA + kstep, voffA); PG8_STAGE(PG8_SB(1, 1), cB + hstep + kstep, voffB);
        PG8_WAIT_V(6); PG8_BAR;
    } else {
        PG8_STAGE(PG8_SB(0, 0), cB, voffB); PG8_STAGE(PG8_SA(0, 0), cA, voffA); PG8_STAGE(PG8_SB(0, 1), cB + hstep, voffB); PG8_STAGE(PG8_SA(0, 1), cA + hstep, voffA);
        if (wr == 1) PG8_BAR;
        PG8_WAIT_V(4); PG8_BAR;
        PG8_STAGE(PG8_SB(1, 0), cB + kstep, voffB); PG8_STAGE(PG8_SA(1, 0), cA + kstep, voffA); PG8_STAGE(PG8_SB(1, 1), cB + hstep + kstep, voffB);
        PG8_WAIT_V(6); PG8_BAR;
    }
    for (;;) {
        const bool has_next = S.next(ui + 1, nxt);
        const char* nA = has_next ? (const char*)g.A + (size_t)nxt.pm * tstep : cA; const char* nB = has_next ? (const char*)g.Bt + (size_t)nxt.pn * tstep : cB;
        for (int t = 0; t < nt; t += 2) {
            const bool last = (t == nt - 2);
            const char* a1 = cA + (size_t)(t + 1) * kstep;
            const char* a2 = last ? nA : cA + (size_t)(t + 2) * kstep; const char* b2 = last ? nB : cB + (size_t)(t + 2) * kstep;
            const char* a3 = a2 + kstep; const char* b3 = b2 + kstep;
            if (last && has_next) S.a_ready(nxt);
            if constexpr (SP2) {
            PG8_LDB(B0, 0, 0); PG8_LDB(B1, 0, 1); PG8_SCHED; PG8_LDA(At, 0, 0); PG8_STAGE(PG8_SA(1, 1), a1 + hstep, voffA);
            PG8_WAIT_V(8); PG8_WAIT_L(0); PG8_BAR; PG8_MMA(0, 0, At, B0); PG8_MMA(0, 1, At, B1); PG8_BAR; PG8_SCHED;
            PG8_LDA(At, 0, 1); PG8_STAGE(PG8_SB(0, 0), b2, voffB); PG8_STAGE(PG8_SB(0, 1), b2 + hstep, voffB); PG8_STAGE(PG8_SA(0, 0), a2, voffA);
            PG8_WAIT_V(8); PG8_WAIT_L(0); PG8_BAR; PG8_MMA(1, 0, At, B0); PG8_MMA(1, 1, At, B1); PG8_BAR; PG8_SCHED;
            PG8_LDB(B0, 1, 0); PG8_LDB(B1, 1, 1); PG8_SCHED; PG8_LDA(At, 1, 0); PG8_STAGE(PG8_SA(0, 1), a2 + hstep, voffA);
            PG8_WAIT_V(8); PG8_WAIT_L(0); PG8_BAR; PG8_MMA(0, 0, At, B0); PG8_MMA(0, 1, At, B1); PG8_BAR; PG8_SCHED;
            PG8_LDA(At, 1, 1); PG8_STAGE(PG8_SB(1, 0), b3, voffB); PG8_STAGE(PG8_SB(1, 1), b3 + hstep, voffB); PG8_STAGE(PG8_SA(1, 0), a3, voffA);
            PG8_WAIT_V(8); PG8_WAIT_L(0); PG8_BAR; PG8_MMA(1, 0, At, B0); PG8_MMA(1, 1, At, B1); PG8_BAR; PG8_SCHED;
            } else {
            PG8_LDB(B0, 0, 0); PG8_SCHED; PG8_LDA(At, 0, 0); PG8_STAGE(PG8_SA(1, 1), a1 + hstep, voffA);
            PG8_WAIT_L(8); PG8_BAR; PG8_WAIT_L(0); PG8_MMA(0, 0, At, B0); PG8_BAR; PG8_SCHED;
            PG8_LDB(B1, 0, 1); PG8_STAGE(PG8_SB(0, 0), b2, voffB);
            PG8_BAR; PG8_WAIT_L(0); PG8_MMA(0, 1, At, B1); PG8_BAR;
            PG8_LDA(At, 0, 1); PG8_STAGE(PG8_SA(0, 0), a2, voffA);
            PG8_BAR; PG8_WAIT_L(0); PG8_MMA(1, 0, At, B0); PG8_BAR; PG8_SCHED;
            PG8_STAGE(PG8_SB(0, 1), b2 + hstep, voffB);
            PG8_WAIT_V(6); PG8_BAR; PG8_MMA(1, 1, At, B1); PG8_BAR;
            PG8_LDB(B0, 1, 0); PG8_SCHED; PG8_LDA(At, 1, 0); PG8_STAGE(PG8_SA(0, 1), a2 + hstep, voffA);
            PG8_WAIT_L(8); PG8_BAR; PG8_WAIT_L(0); PG8_MMA(0, 0, At, B0); PG8_BAR; PG8_SCHED;
            PG8_LDB(B1, 1, 1); PG8_STAGE(PG8_SB(1, 0), b3, voffB);
            PG8_BAR; PG8_WAIT_L(0); PG8_MMA(0, 1, At, B1); PG8_BAR;
            PG8_LDA(At, 1, 1); PG8_STAGE(PG8_SA(1, 0), a3, voffA);
            PG8_BAR; PG8_WAIT_L(0); PG8_MMA(1, 0, At, B0); PG8_BAR; PG8_SCHED;
            PG8_STAGE(PG8_SB(1, 1), b3 + hstep, voffB);
            PG8_WAIT_V(6); PG8_BAR; PG8_MMA(1, 1, At, B1); PG8_BAR;
            }
        }
        if constexpr (ALIGN_EPI) { if (wr == 0) PG8_BAR; }
        if constexpr (!Epi::AFTER_DRAIN) { E(acc, cur, wr, wc, fr, fq); S.done(cur); }
        if (!has_next) break;
#pragma unroll
        for (int a = 0; a < 2; ++a)
#pragma unroll
            for (int b = 0; b < 2; ++b)
#pragma unroll
                for (int m = 0; m < 4; ++m)
#pragma unroll
                    for (int n = 0; n < 2; ++n) acc[a][b][m][n] = (f32x4){0.f, 0.f, 0.f, 0.f};
        cur = nxt; cA = nA; cB = nB; ++ui;
        if constexpr (ALIGN_EPI) { if (wr == 1) PG8_BAR; }
    }
    PG8_WAIT_V(0);
    if constexpr (!ALIGN_EPI) { if (wr == 0) PG8_BAR; }
    PG8_BAR;
    if constexpr (Epi::AFTER_DRAIN) { E.fused(acc, cur, wr, wc, fr, fq, lds, wid, lane); S.done(cur); }
#undef PG8_SA
#undef PG8_SB
#undef PG8_STAGE
#undef PG8_LDA
#undef PG8_LDB
#undef PG8_MMA
#undef PG8_WAIT_V
#undef PG8_WAIT_L
#undef PG8_BAR
#undef PG8_SCHED
}
}
#define PG8_SP2 true

constexpr int NWAVES = 8;
#ifndef MK_N_LAUNCHES
#define MK_N_LAUNCHES 1
#endif
constexpr int N_PHASES = 12;
constexpr int N_LAUNCHES = MK_N_LAUNCHES;

constexpr int NB = 8, T = 2048, D = 1024, M = NB * T, CT = 256, MC = NB * CT, FW = 512, FF = 4096, NMOD = 6 * D;
constexpr float EPS = 1e-6f;

constexpr size_t MiB = 1u << 20;
constexpr size_t WS_CTL = 0, CTL_ZERO_BYTES = 64 * 1024;
constexpr size_t WS_MODF = 1 * MiB;
constexpr size_t WS_POS = 1 * MiB + 256 * 1024;
constexpr size_t WS_WIN = 2 * MiB;
constexpr size_t WS_W1 = 12 * MiB, WS_W2 = 20 * MiB, WS_WOUT = 28 * MiB, WS_WL = 30 * MiB, WS_WF = 32 * MiB, WS_WG = 33 * MiB;
constexpr size_t WS_HCTX = 34 * MiB, WS_UXC = 38 * MiB;
constexpr size_t WS_HLAT = 48 * MiB;
constexpr size_t WS_UX = 80 * MiB;
constexpr size_t WS_PQT = 112 * MiB;
constexpr size_t WS_YF = 144 * MiB;
constexpr size_t WS_DFTM = 160 * MiB;
constexpr size_t WS_HID = 48 * MiB;
constexpr size_t WS_UY = 176 * MiB;
constexpr size_t WS_YB = 208 * MiB;
constexpr size_t WS_END = 240 * MiB;
constexpr int CW_BAR = 1024;

constexpr int RING_OFF = 0, RING_BYTES = 131072;
constexpr int LDSCTL_OFF = RING_BYTES, MISC_OFF = LDSCTL_OFF + 320;
constexpr int LDS_BYTES = 147456;
static_assert(MISC_OFF + 128 <= LDS_BYTES, "LDS map");

#define GAS __attribute__((address_space(1)))
#define LAS __attribute__((address_space(3)))
typedef unsigned short bf16;
typedef unsigned v4u __attribute__((ext_vector_type(4)));
typedef unsigned v2u __attribute__((ext_vector_type(2)));
typedef float f32x4 __attribute__((ext_vector_type(4)));
typedef float f32x16 __attribute__((ext_vector_type(16)));
typedef short bf16x8 __attribute__((ext_vector_type(8)));
typedef GAS unsigned gu32;
#define RLX_AGENT __ATOMIC_RELAXED, __HIP_MEMORY_SCOPE_AGENT
#define LDS_WAIT() asm volatile("s_waitcnt lgkmcnt(0)" ::: "memory")
#define VM_WAIT() asm volatile("s_waitcnt vmcnt(0)" ::: "memory")
#define CBAR() asm volatile("" ::: "memory")
__device__ __forceinline__ unsigned f2bf(float f) { unsigned u = __builtin_bit_cast(unsigned, f); return (u + 0x7fffu + ((u >> 16) & 1u)) >> 16; }
__device__ __forceinline__ unsigned pk2(float lo, float hi) { return f2bf(lo) | (f2bf(hi) << 16); }
__device__ __forceinline__ float bflo(unsigned w) { return __uint_as_float(w << 16); }
__device__ __forceinline__ float bfhi(unsigned w) { return __uint_as_float(w & 0xffff0000u); }
__device__ __forceinline__ float bf1(unsigned short h) { return __uint_as_float(((unsigned)h) << 16); }

#define XB_TMO      128
#define XB_XCNT(j)  (256  + 64 * (j))
#define XB_XSUB(j)  (1280 + 64 * (j))
#define XB_XGEN(j)  (2304 + 64 * (j))
#define XB_TOP      3328
#define XB_TOPGEN   3392
#define XCD_BAR_WORDS 3456
#define XB_SPIN_CAP (1u << 18)

__device__ __forceinline__ unsigned xb_ld(unsigned* p)              { return __hip_atomic_load(p, __ATOMIC_RELAXED, __HIP_MEMORY_SCOPE_AGENT); }
__device__ __forceinline__ unsigned xb_add(unsigned* p, unsigned v) { return __hip_atomic_fetch_add(p, v, __ATOMIC_RELAXED, __HIP_MEMORY_SCOPE_AGENT); }
__device__ __forceinline__ unsigned xb_xcc_id() { return (unsigned)__builtin_amdgcn_s_getreg((3 << 11) | 20) & 0xFu; }
#define XB_SPIN(cond, bar) do { unsigned _sp = 0; while (cond) { __builtin_amdgcn_s_sleep(1); \
    if ((++_sp & 255u) == 0u) { if (xb_ld(&(bar)[XB_TMO])) break; if (_sp > XB_SPIN_CAP) { atomicAdd(&(bar)[XB_TMO], 1u); break; } } } } while (0)

struct XcdBarrier {
    unsigned* bar; unsigned x;
    volatile LAS unsigned* st;
};

__device__ __forceinline__ XcdBarrier xcd_barrier_post(unsigned* bar, volatile LAS unsigned* st) {
    XcdBarrier b; b.bar = bar; b.x = xb_xcc_id(); b.st = st;
    if (threadIdx.x == 0) (void)xb_add(&bar[XB_XCNT(b.x)], 1u);
    return b;
}
__device__ __forceinline__ void xcd_barrier_complete(unsigned* bar, unsigned x, unsigned& nloc, unsigned& nx) {
    const unsigned G = gridDim.x * gridDim.y * gridDim.z;
    unsigned sum, cnt, mine, sp = 0u;
    for (;;) {
        sum = 0u; cnt = 0u; mine = 0u;
#pragma unroll
        for (unsigned j = 0; j < 16; ++j) { const unsigned c = xb_ld(&bar[XB_XCNT(j)]); sum += c; cnt += (c > 0u) ? 1u : 0u; mine = (j == x) ? c : mine; }
        if (sum == G) break;
        __builtin_amdgcn_s_sleep(1);
        if ((++sp & 255u) == 0u) { if (xb_ld(&bar[XB_TMO])) break; if (sp > XB_SPIN_CAP) { atomicAdd(&bar[XB_TMO], 1u); break; } }
    }
    nloc = mine > 0u ? mine : 1u; nx = cnt > 0u ? cnt : 1u;
}

__device__ __forceinline__ void xcd_barrier(const XcdBarrier& b) {
    asm volatile("s_waitcnt vmcnt(0)" ::: "memory");
    __syncthreads();
    if (threadIdx.x == 0) {
        unsigned* bar = b.bar;
        __builtin_amdgcn_s_waitcnt(0);
        unsigned nloc = b.st[0], nx = b.st[1];
        if (nloc == 0u) { xcd_barrier_complete(bar, b.x, nloc, nx); b.st[0] = nloc; b.st[1] = nx; }
        const unsigned old = xb_add(&bar[XB_XSUB(b.x)], 1u);
        const unsigned gen = old / nloc;
        if (old + 1u == (gen + 1u) * nloc) {
            __builtin_amdgcn_fence(__ATOMIC_RELEASE, "agent");
            asm volatile("s_waitcnt vmcnt(0)" ::: "memory");
            const unsigned og = xb_add(&bar[XB_TOP], 1u);
            const unsigned tg = og / nx;
            if (og + 1u == (tg + 1u) * nx) xb_add(&bar[XB_TOPGEN], 1u);
            else XB_SPIN(xb_ld(&bar[XB_TOPGEN]) == tg, bar);
            __builtin_amdgcn_fence(__ATOMIC_ACQUIRE, "agent");
            xb_add(&bar[XB_XGEN(b.x)], 1u);
            asm volatile("s_waitcnt vmcnt(0)" ::: "memory");
        } else {
            XB_SPIN(xb_ld(&bar[XB_XGEN(b.x)]) == gen, bar);
            __builtin_amdgcn_fence(__ATOMIC_ACQUIRE, "agent");
            asm volatile("s_waitcnt vmcnt(0)" ::: "memory");
        }
    }
    __syncthreads();
}

struct Frame {
    LAS unsigned char* lds;
    volatile LAS unsigned* MISC;
    gu32* ctl;
    int tid, lane, wave;
    int vcu, G;
    const float *x, *c, *ctx, *c_ctx, *w_mod, *b_mod, *g_mix, *w_in, *conv_w, *conv_b, *w_a, *b_a, *w_x, *b_x, *lam, *w_lru_out, *w_f_out, *w_out, *g_mlp, *w1, *w2, *g_final;
    float* out;
    float *MODF, *POS;
    bf16 *WIN, *W1T, *W2T, *WOUT, *WL, *WF, *WG, *HCTX, *UXC, *HLAT, *UX, *YF, *PQ, *HID, *UY, *YB, *UG, *XC, *XCC;
};

__device__ __forceinline__ float wave_sum(float v) {
#pragma unroll
    for (int o = 1; o < 64; o <<= 1) v += __shfl_xor(v, o);
    return v;
}
__device__ __forceinline__ float sigm(float x) { return __builtin_amdgcn_rcpf(1.0f + __expf(-x)); }

__device__ __forceinline__ void p0_transpose_item(const float* W, int K, int ldw, int col0, int nblk, bf16* WT, int row_off, LAS float* scr, int item, int lane) {
    const int kb = item / nblk, nb = item % nblk, k0 = 64 * kb, n0 = 32 * nb;
    float tv[32];
#pragma unroll
    for (int i = 0; i < 32; ++i) { const int kk = 2 * i + (lane >> 5); tv[i] = W[(size_t)(k0 + kk) * ldw + col0 + n0 + (lane & 31)]; }
#pragma unroll
    for (int i = 0; i < 32; ++i) { const int kk = 2 * i + (lane >> 5); scr[kk * 33 + (lane & 31)] = tv[i]; }
    LDS_WAIT(); CBAR();
    const int c = lane & 7;
#pragma unroll
    for (int j = 0; j < 4; ++j) { const int n = (lane >> 3) + 8 * j; const LAS float* s = scr + (8 * c) * 33 + n;
        v4u o; o.x = pk2(s[0 * 33], s[1 * 33]); o.y = pk2(s[2 * 33], s[3 * 33]); o.z = pk2(s[4 * 33], s[5 * 33]); o.w = pk2(s[6 * 33], s[7 * 33]);
        *(v4u*)(WT + (size_t)(row_off + n0 + n) * K + k0 + 8 * c) = o; }
    LDS_WAIT(); CBAR();
}

__constant__ float c_trig128[256] = { 1.000000000e+00f, 9.987954562e-01f, 9.951847267e-01f, 9.891765100e-01f, 9.807852804e-01f, 9.700312532e-01f, 9.569403357e-01f, 9.415440652e-01f, 9.238795325e-01f, 9.039892931e-01f, 8.819212643e-01f, 8.577286100e-01f, 8.314696123e-01f, 8.032075315e-01f, 7.730104534e-01f, 7.409511254e-01f, 7.071067812e-01f, 6.715589548e-01f, 6.343932842e-01f, 5.956993045e-01f, 5.555702330e-01f, 5.141027442e-01f, 4.713967368e-01f, 4.275550934e-01f, 3.826834324e-01f, 3.368898534e-01f, 2.902846773e-01f, 2.429801799e-01f, 1.950903220e-01f, 1.467304745e-01f, 9.801714033e-02f, 4.906767433e-02f, 6.123233996e-17f, -4.906767433e-02f, -9.801714033e-02f, -1.467304745e-01f, -1.950903220e-01f, -2.429801799e-01f, -2.902846773e-01f, -3.368898534e-01f, -3.826834324e-01f, -4.275550934e-01f, -4.713967368e-01f, -5.141027442e-01f, -5.555702330e-01f, -5.956993045e-01f, -6.343932842e-01f, -6.715589548e-01f, -7.071067812e-01f, -7.409511254e-01f, -7.730104534e-01f, -8.032075315e-01f, -8.314696123e-01f, -8.577286100e-01f, -8.819212643e-01f, -9.039892931e-01f, -9.238795325e-01f, -9.415440652e-01f, -9.569403357e-01f, -9.700312532e-01f, -9.807852804e-01f, -9.891765100e-01f, -9.951847267e-01f, -9.987954562e-01f, -1.000000000e+00f, -9.987954562e-01f, -9.951847267e-01f, -9.891765100e-01f, -9.807852804e-01f, -9.700312532e-01f, -9.569403357e-01f, -9.415440652e-01f, -9.238795325e-01f, -9.039892931e-01f, -8.819212643e-01f, -8.577286100e-01f, -8.314696123e-01f, -8.032075315e-01f, -7.730104534e-01f, -7.409511254e-01f, -7.071067812e-01f, -6.715589548e-01f, -6.343932842e-01f, -5.956993045e-01f, -5.555702330e-01f, -5.141027442e-01f, -4.713967368e-01f, -4.275550934e-01f, -3.826834324e-01f, -3.368898534e-01f, -2.902846773e-01f, -2.429801799e-01f, -1.950903220e-01f, -1.467304745e-01f, -9.801714033e-02f, -4.906767433e-02f, -1.836970199e-16f, 4.906767433e-02f, 9.801714033e-02f, 1.467304745e-01f, 1.950903220e-01f, 2.429801799e-01f, 2.902846773e-01f, 3.368898534e-01f, 3.826834324e-01f, 4.275550934e-01f, 4.713967368e-01f, 5.141027442e-01f, 5.555702330e-01f, 5.956993045e-01f, 6.343932842e-01f, 6.715589548e-01f, 7.071067812e-01f, 7.409511254e-01f, 7.730104534e-01f, 8.032075315e-01f, 8.314696123e-01f, 8.577286100e-01f, 8.819212643e-01f, 9.039892931e-01f, 9.238795325e-01f, 9.415440652e-01f, 9.569403357e-01f, 9.700312532e-01f, 9.807852804e-01f, 9.891765100e-01f, 9.951847267e-01f, 9.987954562e-01f,
    0.000000000e+00f, 4.906767433e-02f, 9.801714033e-02f, 1.467304745e-01f, 1.950903220e-01f, 2.429801799e-01f, 2.902846773e-01f, 3.368898534e-01f, 3.826834324e-01f, 4.275550934e-01f, 4.713967368e-01f, 5.141027442e-01f, 5.555702330e-01f, 5.956993045e-01f, 6.343932842e-01f, 6.715589548e-01f, 7.071067812e-01f, 7.409511254e-01f, 7.730104534e-01f, 8.032075315e-01f, 8.314696123e-01f, 8.577286100e-01f, 8.819212643e-01f, 9.039892931e-01f, 9.238795325e-01f, 9.415440652e-01f, 9.569403357e-01f, 9.700312532e-01f, 9.807852804e-01f, 9.891765100e-01f, 9.951847267e-01f, 9.987954562e-01f, 1.000000000e+00f, 9.987954562e-01f, 9.951847267e-01f, 9.891765100e-01f, 9.807852804e-01f, 9.700312532e-01f, 9.569403357e-01f, 9.415440652e-01f, 9.238795325e-01f, 9.039892931e-01f, 8.819212643e-01f, 8.577286100e-01f, 8.314696123e-01f, 8.032075315e-01f, 7.730104534e-01f, 7.409511254e-01f, 7.071067812e-01f, 6.715589548e-01f, 6.343932842e-01f, 5.956993045e-01f, 5.555702330e-01f, 5.141027442e-01f, 4.713967368e-01f, 4.275550934e-01f, 3.826834324e-01f, 3.368898534e-01f, 2.902846773e-01f, 2.429801799e-01f, 1.950903220e-01f, 1.467304745e-01f, 9.801714033e-02f, 4.906767433e-02f, 1.224646799e-16f, -4.906767433e-02f, -9.801714033e-02f, -1.467304745e-01f, -1.950903220e-01f, -2.429801799e-01f, -2.902846773e-01f, -3.368898534e-01f, -3.826834324e-01f, -4.275550934e-01f, -4.713967368e-01f, -5.141027442e-01f, -5.555702330e-01f, -5.956993045e-01f, -6.343932842e-01f, -6.715589548e-01f, -7.071067812e-01f, -7.409511254e-01f, -7.730104534e-01f, -8.032075315e-01f, -8.314696123e-01f, -8.577286100e-01f, -8.819212643e-01f, -9.039892931e-01f, -9.238795325e-01f, -9.415440652e-01f, -9.569403357e-01f, -9.700312532e-01f, -9.807852804e-01f, -9.891765100e-01f, -9.951847267e-01f, -9.987954562e-01f, -1.000000000e+00f, -9.987954562e-01f, -9.951847267e-01f, -9.891765100e-01f, -9.807852804e-01f, -9.700312532e-01f, -9.569403357e-01f, -9.415440652e-01f, -9.238795325e-01f, -9.039892931e-01f, -8.819212643e-01f, -8.577286100e-01f, -8.314696123e-01f, -8.032075315e-01f, -7.730104534e-01f, -7.409511254e-01f, -7.071067812e-01f, -6.715589548e-01f, -6.343932842e-01f, -5.956993045e-01f, -5.555702330e-01f, -5.141027442e-01f, -4.713967368e-01f, -4.275550934e-01f, -3.826834324e-01f, -3.368898534e-01f, -2.902846773e-01f, -2.429801799e-01f, -1.950903220e-01f, -1.467304745e-01f, -9.801714033e-02f, -4.906767433e-02f };
__device__ __forceinline__ void p0_prologue(Frame& F) {
    LAS float* sc = (LAS float*)(F.lds);
    LAS float* red = (LAS float*)(F.lds + 36864);
    for (int idx = F.tid; idx < 9 * 1024; idx += NWAVES * 64) { const int r = idx >> 10, k = idx & 1023; const float v = (r < 8) ? F.c[r * 1024 + k] : F.c_ctx[k]; sc[idx] = v * sigm(v); }
    __syncthreads();
    for (int item = F.vcu; item < NMOD / 32; item += F.G) {
        const int n0 = item * 32, kh = F.lane >> 5, nl = F.lane & 31;
        float acc[9];
#pragma unroll
        for (int r = 0; r < 9; ++r) acc[r] = 0.f;
#pragma unroll 1
        for (int i0 = 0; i0 < 64; i0 += 32) { float wv[32];
#pragma unroll
            for (int i = 0; i < 32; ++i) wv[i] = F.w_mod[(size_t)(F.wave * 128 + 2 * (i0 + i) + kh) * NMOD + n0 + nl];
#pragma unroll
            for (int i = 0; i < 32; ++i) { const int k = F.wave * 128 + 2 * (i0 + i) + kh;
#pragma unroll
                for (int r = 0; r < 9; ++r) acc[r] += sc[r * 1024 + k] * wv[i]; } }
#pragma unroll
        for (int r = 0; r < 9; ++r) acc[r] += __shfl_xor(acc[r], 32);
        if (F.lane < 32) {
#pragma unroll
            for (int r = 0; r < 9; ++r) red[(F.wave * 9 + r) * 32 + nl] = acc[r]; }
        __syncthreads();
        if (F.tid < 288) { const int r = F.tid >> 5, n = F.tid & 31; float s = F.b_mod[n0 + n];
#pragma unroll
            for (int w = 0; w < 8; ++w) s += red[(w * 9 + r) * 32 + n];
            F.MODF[r * NMOD + n0 + n] = s; }
        __syncthreads();
    }
    LAS float* scr = (LAS float*)(F.lds + 53248 + F.wave * 8704);
    const int gw = F.vcu * NWAVES + F.wave, NGW = F.G * NWAVES;
    constexpr int I_IN1 = 16 * 64, I_IN2 = 16 * 64, I_W1 = 16 * 128, I_W2 = 64 * 32, I_WO = 16 * 32, I_WLR = 16 * 32, I_WF = 8 * 32, I_G = 16 * 8;
    constexpr int I_PQ = 4 * 2 * 32 * 16, I_POS = 96;
    constexpr int NITEMS = I_IN1 + I_IN2 + I_W1 + I_W2 + I_WO + I_WLR + I_WF + 2 * I_G + I_PQ + I_POS;
    for (int it = gw; it < NITEMS; it += NGW) {
        int r = it;
        if (r < I_IN1) { p0_transpose_item(F.w_in, 1024, 4608, 0, 64, F.WIN, 0, scr, r, F.lane); continue; } r -= I_IN1;
        if (r < I_IN2) { p0_transpose_item(F.w_in, 1024, 4608, 2560, 64, F.WIN, 2048, scr, r, F.lane); continue; } r -= I_IN2;
        if (r < I_W1) { p0_transpose_item(F.w1, 1024, 4096, 0, 128, F.W1T, 0, scr, r, F.lane); continue; } r -= I_W1;
        if (r < I_W2) { p0_transpose_item(F.w2, 4096, 1024, 0, 32, F.W2T, 0, scr, r, F.lane); continue; } r -= I_W2;
        if (r < I_WO) { p0_transpose_item(F.w_out, 1024, 1024, 0, 32, F.WOUT, 0, scr, r, F.lane); continue; } r -= I_WO;
        if (r < I_WLR) { p0_transpose_item(F.w_lru_out, 1024, 1024, 0, 32, F.WL, 0, scr, r, F.lane); continue; } r -= I_WLR;
        if (r < I_WF) { p0_transpose_item(F.w_f_out, 512, 1024, 0, 32, F.WF, 0, scr, r, F.lane); continue; } r -= I_WF;
        if (r < I_G) { const int mat = r >> 3;
            p0_transpose_item(F.w_a + (size_t)mat * 16384, 128, 128, 0, 4, F.WG, mat * 256, scr, r & 7, F.lane); continue; } r -= I_G;
        if (r < I_G) { const int mat = r >> 3;
            p0_transpose_item(F.w_x + (size_t)mat * 16384, 128, 128, 0, 4, F.WG, mat * 256 + 128, scr, r & 7, F.lane); continue; } r -= I_G;
        if (r < I_PQ) {
            const int kc = r & 15, mc = (r >> 4) & 31, pq = (r >> 9) & 1, g = r >> 10;
            const int k = kc * 64 + F.lane, m0 = mc * 4;
            const float* wrow = F.w_in + (size_t)k * 4608 + 2048 + g * 128;
            const float* tg = c_trig128 + pq * 128;
            float acc[4] = {0.f, 0.f, 0.f, 0.f};
#pragma unroll 4
            for (int c4 = 0; c4 < 32; ++c4) { const f32x4 w4 = *(const f32x4*)(wrow + 4 * c4);
#pragma unroll
                for (int cc = 0; cc < 4; ++cc) { const int c = 4 * c4 + cc;
#pragma unroll
                    for (int mm = 0; mm < 4; ++mm) acc[mm] += tg[((m0 + mm) * c) & 127] * w4[cc]; } }
#pragma unroll
            for (int mm = 0; mm < 4; ++mm) F.WIN[(size_t)(4096 + pq * 512 + g * 128 + m0 + mm) * 1024 + k] = (bf16)f2bf(acc[mm] * (1.0f / 512.0f));
            continue; } r -= I_PQ;
        {
            const float p = (float)(r < 32 ? r : r - 32);
#pragma unroll
            for (int j = 0; j < 8; ++j) { const int ch = j * 64 + F.lane, i = ch & 255;
                const float freq = expf(-9.210340371976184f * (float)i / 256.0f); const float ang = p * freq;
                float s, c; sincospif(ang * 0.3183098861837907f, &s, &c);
                F.POS[r * 512 + ch] = (ch < 256) ? s : c; }
        }
    }
}

template <int MODE> __device__ __forceinline__ void norm_rows(Frame& F) {
    const int gw = F.vcu * NWAVES + F.wave, NGW = F.G * NWAVES;
    const int nrows = (MODE == 0) ? (M + MC) : M;
    const float* gvec = (MODE == 0) ? F.g_mix : (MODE == 1 ? F.g_mlp : F.g_final);
    f32x4 g[4];
#pragma unroll
    for (int j = 0; j < 4; ++j) g[j] = *(const f32x4*)(gvec + 256 * j + 4 * F.lane);
    f32x4 vn[4];
    {   const int row = gw < nrows ? gw : 0; const bool lat = row < M;
        const float* src = (MODE == 0) ? (lat ? F.x + (size_t)row * D : F.ctx + (size_t)(row - M) * D) : F.out + (size_t)row * D;
#pragma unroll
        for (int j = 0; j < 4; ++j) vn[j] = *(const f32x4*)(src + 256 * j + 4 * F.lane); }
    for (int row = gw; row < nrows; row += NGW) {
        const bool lat = row < M;
        f32x4 v[4]; float ss = 0.f;
#pragma unroll
        for (int j = 0; j < 4; ++j) v[j] = vn[j];
        {   const int rn = (row + NGW < nrows) ? row + NGW : row; const bool latn = rn < M;
            const float* srcn = (MODE == 0) ? (latn ? F.x + (size_t)rn * D : F.ctx + (size_t)(rn - M) * D) : F.out + (size_t)rn * D;
#pragma unroll
            for (int j = 0; j < 4; ++j) vn[j] = *(const f32x4*)(srcn + 256 * j + 4 * F.lane); }
        if (MODE == 0 && lat) { const int t = row & (T - 1);
#pragma unroll
            for (int j = 0; j < 4; ++j) { const int c = 256 * j + 4 * F.lane;
                const f32x4 pv = (j < 2) ? *(const f32x4*)(F.POS + (t >> 6) * 512 + c) : *(const f32x4*)(F.POS + 32 * 512 + (t & 63) * 512 + (c - 512));
                v[j] = v[j] + pv; } }
#pragma unroll
        for (int j = 0; j < 4; ++j) ss += (v[j].x * v[j].x + v[j].y * v[j].y) + (v[j].z * v[j].z + v[j].w * v[j].w);
        const float rstd = 1.0f / sqrtf(wave_sum(ss) * (1.0f / D) + EPS);
        if (MODE == 2) {
#pragma unroll
            for (int j = 0; j < 4; ++j) *(f32x4*)(F.out + (size_t)row * D + 256 * j + 4 * F.lane) = v[j] * rstd * g[j];
        } else {
            const int mrow = lat ? (row >> 11) : 8;
            const float* mod = F.MODF + (size_t)mrow * NMOD + (MODE == 0 ? 0 : 3072);
            bf16* dst = (MODE == 0) ? (lat ? F.HLAT + (size_t)row * D : F.HCTX + (size_t)(row - M) * D) : F.UY + (size_t)row * D;
#pragma unroll
            for (int j = 0; j < 4; ++j) { const int c = 256 * j + 4 * F.lane;
                const f32x4 sh = *(const f32x4*)(mod + c), scl = *(const f32x4*)(mod + 1024 + c);
                const f32x4 h = v[j] * rstd * g[j] * (scl + 1.0f) + sh;
                v2u o; o.x = pk2(h.x, h.y); o.y = pk2(h.z, h.w);
                *(v2u*)(dst + c) = o; }
        }
    }
}

__device__ __forceinline__ void conv_phase(Frame& F) {
    const int gw = F.vcu * NWAVES + F.wave, NGW = F.G * NWAVES, lane = F.lane;
    for (int it = gw; it < 4608; it += NGW) {
        const bool lat = it < 4096; const int r = lat ? it : it - 4096;
        const int half = r & 1, row0 = (r >> 1) * 8;
        const int Tseg = lat ? T : CT; const int t0 = row0 & (Tseg - 1);
        const int c0 = half * 512 + lane * 8;
        const bf16* src = (lat ? F.UX : F.UXC) + (size_t)(row0 - t0) * D + c0;
        bf16* dst = (lat ? F.XC : F.XCC) + (size_t)(row0 - t0) * D + c0;
        v4u v[11];
#pragma unroll
        for (int i = 0; i < 11; ++i) { const int tt = t0 - 2 + i; v[i] = (tt >= 0 && tt < Tseg) ? *(const v4u*)(src + (size_t)tt * D) : (v4u){0u, 0u, 0u, 0u}; }
        f32x4 cw[4][2], cb[2];
#pragma unroll
        for (int k = 0; k < 4; ++k) { cw[k][0] = *(const f32x4*)(F.conv_w + k * 1024 + c0); cw[k][1] = *(const f32x4*)(F.conv_w + k * 1024 + c0 + 4); }
        cb[0] = *(const f32x4*)(F.conv_b + c0); cb[1] = *(const f32x4*)(F.conv_b + c0 + 4);
#pragma unroll
        for (int o = 0; o < 8; ++o) { f32x4 x0 = cb[0], x1 = cb[1];
#pragma unroll
            for (int k = 0; k < 4; ++k) { const v4u u = v[o + k];
                x0[0] += cw[k][0][0] * bflo(u.x); x0[1] += cw[k][0][1] * bfhi(u.x); x0[2] += cw[k][0][2] * bflo(u.y); x0[3] += cw[k][0][3] * bfhi(u.y);
                x1[0] += cw[k][1][0] * bflo(u.z); x1[1] += cw[k][1][1] * bfhi(u.z); x1[2] += cw[k][1][2] * bflo(u.w); x1[3] += cw[k][1][3] * bfhi(u.w); }
            *(v4u*)(dst + (size_t)(t0 + o) * D) = pg8::pack8(x0, x1); }
    }
}


constexpr int FT_ZROW = 144, FT_GROW = 80;
__device__ __forceinline__ void fft_phase(Frame& F) {
    const int w = F.wave;
    LAS unsigned char* zs = F.lds;
    const int mtile = w & 3, nhalf = w >> 2;
    bf16x8 A1[8], A2[4];
    {   const int lane = F.lane, h = lane >> 5, cl = lane & 31; const int ri = cl >> 4, k1 = 16 * mtile + (cl & 15);
#pragma unroll
        for (int ks = 0; ks < 8; ++ks) { const int pq = ks >> 2;
#pragma unroll
            for (int j = 0; j < 8; ++j) { const int t1 = 16 * (ks & 3) + 8 * h + j; const int ix = 2 * ((k1 * t1) & 63); const float c = c_trig128[ix], s = c_trig128[128 + ix];
                const float v = (ri == 0) ? (pq == 0 ? c : -s) : (pq == 0 ? s : c);
                A1[ks][j] = (short)f2bf(v); } }
#pragma unroll
        for (int ks = 0; ks < 4; ++ks) { const int ri2 = ks >> 1;
#pragma unroll
            for (int j = 0; j < 8; ++j) { const int t2 = 16 * (ks & 1) + 8 * h + j; const int ix = 4 * ((cl * t2) & 31); const float c = c_trig128[ix], s = c_trig128[128 + ix];
                A2[ks][j] = (short)f2bf(ri2 == 0 ? c : -s); } }
    }
    for (int item = F.vcu; item < NB * 64; item += F.G) {
        const int b = item >> 6, c0 = (item & 63) * 8;
        int lv = F.lane; asm volatile("" : "+v"(lv));
        const int lane = lv, h = lane >> 5, cl = lane & 31;
        {   v4u zv[8];
#pragma unroll
            for (int j = 0; j < 8; ++j) { const int u = w * 8 + j, pq = u >> 5, t2 = u & 31;
                zv[j] = *(const v4u*)(F.PQ + ((size_t)b * T + 32 * lane + t2) * D + pq * 512 + c0); }
#pragma unroll
            for (int j = 0; j < 8; ++j) { const int u = w * 8 + j;
                LAS unsigned char* zp = zs + (u * 8) * FT_ZROW + lane * 2;
                *(LAS unsigned short*)(zp + 0 * FT_ZROW) = (unsigned short)(zv[j].x & 0xffffu); *(LAS unsigned short*)(zp + 1 * FT_ZROW) = (unsigned short)(zv[j].x >> 16);
                *(LAS unsigned short*)(zp + 2 * FT_ZROW) = (unsigned short)(zv[j].y & 0xffffu); *(LAS unsigned short*)(zp + 3 * FT_ZROW) = (unsigned short)(zv[j].y >> 16);
                *(LAS unsigned short*)(zp + 4 * FT_ZROW) = (unsigned short)(zv[j].z & 0xffffu); *(LAS unsigned short*)(zp + 5 * FT_ZROW) = (unsigned short)(zv[j].z >> 16);
                *(LAS unsigned short*)(zp + 6 * FT_ZROW) = (unsigned short)(zv[j].w & 0xffffu); *(LAS unsigned short*)(zp + 7 * FT_ZROW) = (unsigned short)(zv[j].w >> 16); }
        }
        __syncthreads();
        f32x16 acc[4];
#pragma unroll
        for (int nt = 0; nt < 4; ++nt)
#pragma unroll
            for (int i = 0; i < 16; ++i) acc[nt][i] = 0.f;
#pragma unroll
        for (int ks = 0; ks < 8; ++ks) { const int pq = ks >> 2;
#pragma unroll
            for (int nt = 0; nt < 4; ++nt) { const int ng = (nhalf * 4 + nt) * 32 + cl;
                const bf16x8 bf = *(const LAS bf16x8*)(zs + (pq * 256 + ng) * FT_ZROW + (16 * (ks & 3) + 8 * h) * 2);
                acc[nt] = __builtin_amdgcn_mfma_f32_32x32x16_bf16(A1[ks], bf, acc[nt], 0, 0, 0); } }
        __syncthreads();
#pragma unroll
        for (int nt = 0; nt < 4; ++nt) { const int ng = (nhalf * 4 + nt) * 32 + cl, t2 = ng >> 3, c = ng & 7;
            float sb, cb, s1, c1, s8, c8;
            sincospif((float)((16 * mtile + 4 * h) * t2) * (1.0f / 1024.0f), &sb, &cb);
            sincospif((float)t2 * (1.0f / 1024.0f), &s1, &c1);
            sincospif((float)(8 * t2) * (1.0f / 1024.0f), &s8, &c8);
#pragma unroll
            for (int r = 0; r < 8; ++r) { const int k1 = 16 * mtile + (r & 3) + 8 * (r >> 2) + 4 * h;
                if (r == 4) { const float cn = cb * c8 - sb * s8, sn = sb * c8 + cb * s8; cb = cn; sb = sn; }
                float cp = cb, sp = sb;
                if ((r & 3) >= 1) { const float cn = cp * c1 - sp * s1, sn = sp * c1 + cp * s1; cp = cn; sp = sn; }
                if ((r & 3) >= 2) { const float cn = cp * c1 - sp * s1, sn = sp * c1 + cp * s1; cp = cn; sp = sn; }
                if ((r & 3) >= 3) { const float cn = cp * c1 - sp * s1, sn = sp * c1 + cp * s1; cp = cn; sp = sn; }
                const float re = acc[nt][r], im = acc[nt][r + 8];
                const float re2 = re * cp - im * sp, im2 = re * sp + im * cp;
                *(LAS unsigned short*)(zs + ((k1) * 8 + c) * FT_GROW + t2 * 2) = (unsigned short)f2bf(re2);
                *(LAS unsigned short*)(zs + ((64 + k1) * 8 + c) * FT_GROW + t2 * 2) = (unsigned short)f2bf(im2); } }
        __syncthreads();
        f32x16 acc2[2];
#pragma unroll
        for (int nt = 0; nt < 2; ++nt)
#pragma unroll
            for (int i = 0; i < 16; ++i) acc2[nt][i] = 0.f;
#pragma unroll
        for (int ks = 0; ks < 4; ++ks) { const int ri2 = ks >> 1;
#pragma unroll
            for (int nt = 0; nt < 2; ++nt) { const int ng = (2 * w + nt) * 32 + cl;
                const bf16x8 bf = *(const LAS bf16x8*)(zs + (ri2 * 512 + ng) * FT_GROW + (16 * (ks & 1) + 8 * h) * 2);
                acc2[nt] = __builtin_amdgcn_mfma_f32_32x32x16_bf16(A2[ks], bf, acc2[nt], 0, 0, 0); } }
#pragma unroll
        for (int nt = 0; nt < 2; ++nt) { const int ng = (2 * w + nt) * 32 + cl, k1 = ng >> 3, c = ng & 7;
#pragma unroll
            for (int reg = 0; reg < 16; ++reg) { const int k2 = (reg & 3) + 8 * (reg >> 2) + 4 * h;
                F.YF[((size_t)b * T + k1 + 64 * k2) * FW + c0 + c] = (bf16)f2bf(acc2[nt][reg]); } }
        __syncthreads();
    }
}

constexpr int SC_W = 0;
constexpr int SC_TAB = 2 * 64 * 272;
template <int DIR>
__device__ __forceinline__ void scan_pass(Frame& F, int b, int hd, int q, float& carry, int& round, bf16* ya_dst) {
    const int lane = F.lane, w = F.wave, h = lane >> 5, cl = lane & 31;
    const LAS unsigned char* wl = F.lds + SC_W + DIR * (64 * 272);
    LAS float* tab = (LAS float*)(F.lds + SC_TAB);
    const int ch = hd * 128 + q * 32 + cl;
    constexpr float L2E = 1.4426950408889634f;
    const float cr = -F.b_a[DIR * 1024 + ch] * L2E, ci = -F.b_x[DIR * 1024 + ch] * L2E;
    const float nsp8 = -8.0f * log1pf(expf(-F.lam[DIR * 1024 + ch]));
    const float nsp8l = nsp8 * L2E;
    bf16x8 I0, I1;
#pragma unroll
    for (int j = 0; j < 8; ++j) { I0[j] = (8 * h + j == cl) ? (short)0x3F80 : (short)0; I1[j] = (16 + 8 * h + j == cl) ? (short)0x3F80 : (short)0; }
    const bf16* xlat = F.XC + (size_t)b * T * D + hd * 128 + 8 * h + (size_t)cl * D;
    const bf16* xctx = F.XCC + (size_t)b * CT * D + hd * 128 + 8 * h + (size_t)cl * D;
#define SC_R0(R_) ((R_) == 0 ? 0 : ((DIR == 0) ? ((R_) - 1) : (4 - (R_))) * 512)
#define SC_PTR(R_, mt_) (((R_) == 0 ? xctx : xlat) + (size_t)(SC_R0(R_) + 64 * w + 32 * (mt_)) * D)
#define SC_LOADX(X_, R_, mt_) do { const bf16* p_ = SC_PTR(R_, mt_); _Pragma("unroll") for (int ks_ = 0; ks_ < 8; ++ks_) X_[ks_] = *(const bf16x8*)(p_ + ks_ * 16); } while (0)
    bf16x8 X0[8], X1[8];
    const int firstR = (w < 4) ? 0 : 1;
    SC_LOADX(X0, firstR, 0);
#pragma unroll 1
    for (int R = 0; R < 5; ++R) {
        const int r0 = SC_R0(R);
        const int nact = (R == 0) ? 4 : 8;
        const bool active = w < nact;
        const int t0 = r0 + 64 * w;
        float av[2][16], bv[2][16];
        float preA[8], preH[8];
        bf16x8 Yh[2][2], Yu[2][2];
#define SC_LOADY(mt_) do { _Pragma("unroll") for (int s_ = 0; s_ < 2; ++s_) { const size_t o_ = ((size_t)b * T + t0 + 32 * (mt_) + cl) * D + hd * 128 + q * 32 + 16 * s_ + 8 * h; \
            Yh[mt_][s_] = *(const bf16x8*)(F.HLAT + o_); Yu[mt_][s_] = *(const bf16x8*)(F.UY + o_); } } while (0)
        if (active) {
#pragma unroll
            for (int mt = 0; mt < 2; ++mt) {
                if (mt == 0) SC_LOADX(X1, R, 1); else { const int Rn = (R < 4) ? R + 1 : R; SC_LOADX(X0, Rn, 0); }
                f32x16 accr, acci, accx;
#pragma unroll
                for (int i = 0; i < 16; ++i) { accr[i] = 0.f; acci[i] = 0.f; accx[i] = 0.f; }
#pragma unroll
                for (int ks = 0; ks < 8; ++ks) { const bf16x8 af = (mt == 0) ? X0[ks] : X1[ks];
                    const bf16x8 br = *(const LAS bf16x8*)(wl + cl * 272 + (ks * 16 + 8 * h) * 2);
                    const bf16x8 bi = *(const LAS bf16x8*)(wl + (32 + cl) * 272 + (ks * 16 + 8 * h) * 2);
                    accr = __builtin_amdgcn_mfma_f32_32x32x16_bf16(af, br, accr, 0, 0, 0);
                    acci = __builtin_amdgcn_mfma_f32_32x32x16_bf16(af, bi, acci, 0, 0, 0); }
                __builtin_amdgcn_sched_barrier(0);
                {
                    bf16x8 fa, fb;
                    if (mt == 0) { fa = (q == 0) ? X0[0] : (q == 1) ? X0[2] : (q == 2) ? X0[4] : X0[6]; fb = (q == 0) ? X0[1] : (q == 1) ? X0[3] : (q == 2) ? X0[5] : X0[7]; }
                    else         { fa = (q == 0) ? X1[0] : (q == 1) ? X1[2] : (q == 2) ? X1[4] : X1[6]; fb = (q == 0) ? X1[1] : (q == 1) ? X1[3] : (q == 2) ? X1[5] : X1[7]; }
                    accx = __builtin_amdgcn_mfma_f32_32x32x16_bf16(fa, I0, accx, 0, 0, 0);
                    accx = __builtin_amdgcn_mfma_f32_32x32x16_bf16(fb, I1, accx, 0, 0, 0); }
                __builtin_amdgcn_sched_barrier(0);
#pragma unroll
                for (int reg = 0; reg < 16; ++reg) {
                    const float e1 = __builtin_amdgcn_exp2f(accr[reg] * (-L2E) + cr), e2 = __builtin_amdgcn_exp2f(acci[reg] * (-L2E) + ci);
                    const float rg = __builtin_amdgcn_rcpf(1.0f + e1), ig = __builtin_amdgcn_rcpf(1.0f + e2);
                    const float a = __builtin_amdgcn_exp2f(nsp8l * rg);
                    const float x2 = 2.0f * nsp8 * rg;
                    float pz = x2 * (1.0f / 24.0f) + (1.0f / 6.0f); pz = pz * x2 + 0.5f; pz = pz * x2 + 1.0f;
                    const float m2 = (x2 > -0.3f) ? (-x2 * pz) : (1.0f - a * a);
                    av[mt][reg] = a; bv[mt][reg] = __builtin_amdgcn_sqrtf(m2) * ig * accx[reg]; }
                __builtin_amdgcn_sched_barrier(0);
            }
            __builtin_amdgcn_sched_barrier(0);
            float gA[8], gH[8];
#pragma unroll
            for (int mt = 0; mt < 2; ++mt)
#pragma unroll
                for (int g4 = 0; g4 < 4; ++g4) { float ar = 1.f, hr = 0.f;
#pragma unroll
                    for (int ii = 0; ii < 4; ++ii) { const int i = g4 * 4 + (DIR == 0 ? ii : 3 - ii);
                        hr = av[mt][i] * hr + bv[mt][i]; ar = ar * av[mt][i]; av[mt][i] = ar; bv[mt][i] = hr; }
                    gA[mt * 4 + g4] = ar; gH[mt * 4 + g4] = hr; }
            float pA[8], pH[8];
#pragma unroll
            for (int gi = 0; gi < 8; ++gi) { pA[gi] = __shfl_xor(gA[gi], 32); pH[gi] = __shfl_xor(gH[gi], 32); }
            float Ar = 1.f, Hr = 0.f;
#pragma unroll
            for (int gg = 0; gg < 8; ++gg) { const int gi = (DIR == 0) ? gg : 7 - gg;
                const bool own_first = (DIR == 0) ? (h == 0) : (h == 1);
                const float fA = own_first ? gA[gi] : pA[gi], fH = own_first ? gH[gi] : pH[gi];
                const float sA = own_first ? pA[gi] : gA[gi], sH = own_first ? pH[gi] : gH[gi];
                const float Ar1 = fA * Ar, Hr1 = fA * Hr + fH;
                preA[gi] = own_first ? Ar : Ar1; preH[gi] = own_first ? Hr : Hr1;
                Ar = sA * Ar1; Hr = sA * Hr1 + sH; }
            __builtin_amdgcn_sched_barrier(0);
            if (DIR == 1 && R > 0) SC_LOADY(0);
            if (lane < 32) { tab[((round & 1) * 8 + w) * 64 + cl] = Ar; tab[((round & 1) * 8 + w) * 64 + 32 + cl] = Hr; }
        }
        __syncthreads();
        float my = carry; { float c = carry;
#pragma unroll
            for (int ww = 0; ww < 8; ++ww) { const int w2 = (DIR == 0) ? ww : 7 - ww;
                if (w2 < nact) { if (w2 == w) my = c; c = tab[((round & 1) * 8 + w2) * 64 + cl] * c + tab[((round & 1) * 8 + w2) * 64 + 32 + cl]; } }
            carry = c; }
        ++round;
        if (active && R > 0) {
            if (DIR == 1) SC_LOADY(1);
#pragma unroll
            for (int mt = 0; mt < 2; ++mt) {
                f32x16 hfC, gyC;
                if (DIR == 1) {
#pragma unroll
                    for (int i = 0; i < 16; ++i) { hfC[i] = 0.f; gyC[i] = 0.f; }
                    hfC = __builtin_amdgcn_mfma_f32_32x32x16_bf16(Yh[mt][0], I0, hfC, 0, 0, 0); hfC = __builtin_amdgcn_mfma_f32_32x32x16_bf16(Yh[mt][1], I1, hfC, 0, 0, 0);
                    gyC = __builtin_amdgcn_mfma_f32_32x32x16_bf16(Yu[mt][0], I0, gyC, 0, 0, 0); gyC = __builtin_amdgcn_mfma_f32_32x32x16_bf16(Yu[mt][1], I1, gyC, 0, 0, 0); }
#pragma unroll
                for (int reg = 0; reg < 16; ++reg) { const int gi = mt * 4 + (reg >> 2);
                    const float gc = preH[gi] + preA[gi] * my;
                    const float hv = bv[mt][reg] + av[mt][reg] * gc;
                    const int tok = t0 + 32 * mt + 8 * (reg >> 2) + 4 * h + (reg & 3);
                    const size_t idx = ((size_t)b * T + tok) * D + ch;
                    if (DIR == 0) F.HLAT[idx] = (bf16)(pg8::cvt_pk_bf16(hv, hv) & 0xffffu);
                    else { const float y = (hfC[reg] + hv) * gyC[reg]; ya_dst[idx] = (bf16)(pg8::cvt_pk_bf16(y, y) & 0xffffu); } }
            }
        }
    }
#undef SC_R0
#undef SC_PTR
#undef SC_LOADX
#undef SC_LOADY
}
__device__ __forceinline__ void scan_phase(Frame& F, bf16* ya_dst) {
    int round = 0;
    for (int item = F.vcu; item < NB * 8 * 4; item += F.G) {
        const int q = item & 3, hd = (item >> 2) & 7, b = item >> 5;
        for (int i = F.tid; i < 2048; i += NWAVES * 64) { const int ck = i & 15, row = (i >> 4) & 63, dir = i >> 10; const int g = row >> 5, e = row & 31;
            const v4u v = *(const v4u*)(F.WG + ((size_t)((dir * 8 + hd) * 256 + g * 128 + q * 32 + e)) * 128 + ck * 8);
            *(LAS v4u*)(F.lds + SC_W + dir * (64 * 272) + row * 272 + ck * 16) = v; }
        __syncthreads();
        float carry = 0.f;
        scan_pass<0>(F, b, hd, q, carry, round, ya_dst);
        VM_WAIT(); __syncthreads();
        carry = 0.f;
        scan_pass<1>(F, b, hd, q, carry, round, ya_dst);
        __syncthreads();
    }
}

struct Args { const float* in[22]; float* out; unsigned char* ws; int ph_lo, ph_hi; };
__global__ void __launch_bounds__(NWAVES * 64, 2) mk_fwd(Args args) {
    extern __shared__ __attribute__((aligned(16))) unsigned char lds[];
    Frame F;
    F.lds = (LAS unsigned char*)lds;
    F.MISC = (volatile LAS unsigned*)(F.lds + MISC_OFF);
    F.tid = threadIdx.x; F.lane = F.tid & 63; F.wave = __builtin_amdgcn_readfirstlane(F.tid >> 6);
    F.G = gridDim.x; { const int bx = blockIdx.x; F.vcu = (F.G % 8 == 0) ? (bx % 8) * (F.G / 8) + bx / 8 : bx; }
    unsigned char* ws = args.ws;
    F.ctl = (gu32*)(ws + WS_CTL);
    F.x = args.in[0]; F.c = args.in[1]; F.ctx = args.in[2]; F.c_ctx = args.in[3]; F.w_mod = args.in[4]; F.b_mod = args.in[5]; F.g_mix = args.in[6]; F.w_in = args.in[7];
    F.conv_w = args.in[8]; F.conv_b = args.in[9]; F.w_a = args.in[10]; F.b_a = args.in[11]; F.w_x = args.in[12]; F.b_x = args.in[13]; F.lam = args.in[14];
    F.w_lru_out = args.in[15]; F.w_f_out = args.in[16]; F.w_out = args.in[17]; F.g_mlp = args.in[18]; F.w1 = args.in[19]; F.w2 = args.in[20]; F.g_final = args.in[21];
    F.out = args.out;
    F.MODF = (float*)(ws + WS_MODF); F.POS = (float*)(ws + WS_POS);
    F.WIN = (bf16*)(ws + WS_WIN); F.W1T = (bf16*)(ws + WS_W1); F.W2T = (bf16*)(ws + WS_W2); F.WOUT = (bf16*)(ws + WS_WOUT); F.WL = (bf16*)(ws + WS_WL); F.WF = (bf16*)(ws + WS_WF); F.WG = (bf16*)(ws + WS_WG);
    F.HCTX = (bf16*)(ws + WS_HCTX); F.UXC = (bf16*)(ws + WS_UXC); F.HLAT = (bf16*)(ws + WS_HLAT); F.UX = (bf16*)(ws + WS_UX); F.PQ = (bf16*)(ws + WS_PQT); F.YF = (bf16*)(ws + WS_YF);
    F.HID = (bf16*)(ws + WS_HID); F.UY = (bf16*)(ws + WS_UY); F.YB = (bf16*)(ws + WS_YB); F.UG = (bf16*)args.out; F.XC = F.YB; F.XCC = F.HCTX;
    for (int u = F.tid; u < (LDS_BYTES - LDSCTL_OFF) / 4; u += NWAVES * 64) ((LAS unsigned*)(F.lds + LDSCTL_OFF))[u] = 0u;
    __syncthreads();
    const bool one_launch = (args.ph_hi - args.ph_lo) > 1;
    XcdBarrier bar; bar.bar = (unsigned*)(F.ctl + CW_BAR); bar.x = 0; bar.st = nullptr;
    if (one_launch) bar = xcd_barrier_post((unsigned*)(F.ctl + CW_BAR), F.MISC + 8);
    const int lo = args.ph_lo, hi = args.ph_hi;
#ifdef ONLY_PH
#define IN(k) ((k) == ONLY_PH)
#else
#define IN(k) (lo <= (k) && (k) < hi)
#endif
#define SEAM(k) do { if (IN(k) && IN((k) + 1)) xcd_barrier(bar); } while (0)
    using pg8::Gemm; using pg8::StaticOrder;
    const int cid = (int)blockIdx.x;

#ifndef REP_PH
#define REP_PH -1
#define REP_N 1
#endif
#define REPS(k) ((k) == REP_PH ? REP_N : 1)
#define REPBAR(k) do { if (rep + 1 < REPS(k)) xcd_barrier(bar); } while (0)
    int ph = 0;
#define PHASE_BEGIN if (IN(ph)) { for (int rep = 0; rep < REPS(ph); ++rep) {
#define PHASE_END   REPBAR(ph); } SEAM(ph); } ++ph;
    PHASE_BEGIN p0_prologue(F); PHASE_END
    PHASE_BEGIN norm_rows<0>(F); PHASE_END
    PHASE_BEGIN
        { Gemm g{F.HLAT, F.WIN, M, 5120, D}; StaticOrder S; S.init(M, 5120, F.G, cid); pg8::EpiInMain E{F.UX, F.UY, F.UG, F.PQ};
          pg8::gemm_phase<pg8::EpiInMain, StaticOrder, true, true>(F.lds + RING_OFF, g, S, E); }
        { Gemm g{F.HCTX, F.WIN, MC, 1024, D}; StaticOrder S; S.init(MC, 1024, F.G, cid); pg8::EpiBf16<0> E{F.UXC, D};
          pg8::gemm_phase<pg8::EpiBf16<0>, StaticOrder, true, true>(F.lds + RING_OFF, g, S, E); }
    PHASE_END
#ifndef NO_CONV
    PHASE_BEGIN conv_phase(F);
#else
    PHASE_BEGIN
#endif
#ifndef NO_FFT
    fft_phase(F);
#endif
    PHASE_END
    PHASE_BEGIN scan_phase(F, rep + 1 < REPS(ph) ? F.UX : F.UY); PHASE_END
    PHASE_BEGIN
        Gemm g{F.YF, F.WF, M, D, FW}; StaticOrder S; S.init(M, D, F.G, cid); pg8::EpiGate<false> E{F.YB, D, F.UG + 1024, 2048, nullptr};
        pg8::gemm_phase<pg8::EpiGate<false>, StaticOrder, true, true>(F.lds + RING_OFF, g, S, E);
    PHASE_END
    PHASE_BEGIN
        Gemm g{F.UY, F.WL, M, D, D}; StaticOrder S; S.init(M, D, F.G, cid); pg8::EpiGate<true> E{F.UX, D, F.UG, 2048, F.YB};
        pg8::gemm_phase<pg8::EpiGate<true>, StaticOrder, true, true>(F.lds + RING_OFF, g, S, E);
    PHASE_END
    PHASE_BEGIN
        Gemm g{F.UX, F.WOUT, M, D, D}; StaticOrder S; S.init(M, D, F.G, cid); pg8::EpiResid<0> E{F.x, F.out, F.MODF + 2048, F.POS};
        pg8::gemm_phase<pg8::EpiResid<0>, StaticOrder, true, true>(F.lds + RING_OFF, g, S, E);
    PHASE_END
    PHASE_BEGIN norm_rows<1>(F); PHASE_END
    PHASE_BEGIN
        Gemm g{F.UY, F.W1T, M, FF, D}; StaticOrder S; S.init(M, FF, F.G, cid); pg8::EpiBf16<1> E{F.HID, FF};
        pg8::gemm_phase<pg8::EpiBf16<1>, StaticOrder, true, true>(F.lds + RING_OFF, g, S, E);
    PHASE_END
    PHASE_BEGIN
        Gemm g{F.HID, F.W2T, M, D, FF}; StaticOrder S; S.init(M, D, F.G, cid); pg8::EpiResid<1> E{nullptr, F.out, F.MODF + 5120, nullptr};
        pg8::gemm_phase<pg8::EpiResid<1>, StaticOrder, true, true>(F.lds + RING_OFF, g, S, E);
    PHASE_END
    PHASE_BEGIN norm_rows<2>(F); PHASE_END
#undef IN
#undef SEAM
}

extern "C" void kernel_launch(void* const* d_in, const int* in_sizes, int n_in, void* d_out, int out_size, void* d_ws, size_t ws_size, hipStream_t stream) {
    static int grid = 0;
    if (grid == 0) {
        if (n_in != 22 || in_sizes[0] != M * D || out_size != M * D || ws_size < WS_END) { fprintf(stderr, "kernel_launch: unexpected shapes (n_in %d, in0 %d, out %d, ws %zu); nothing launched\n", n_in, n_in > 0 ? in_sizes[0] : -1, out_size, ws_size); grid = -1; return; }
        int dev = 0, cus = 0, per_cu = 0;
        if (hipGetDevice(&dev) != hipSuccess || hipDeviceGetAttribute(&cus, hipDeviceAttributeMultiprocessorCount, dev) != hipSuccess) { fprintf(stderr, "kernel_launch: device query failed\n"); grid = -1; return; }
        if (hipFuncSetAttribute((const void*)mk_fwd, hipFuncAttributeMaxDynamicSharedMemorySize, LDS_BYTES) != hipSuccess) { fprintf(stderr, "kernel_launch: hipFuncSetAttribute failed\n"); grid = -1; return; }
        if (hipOccupancyMaxActiveBlocksPerMultiprocessor(&per_cu, (const void*)mk_fwd, NWAVES * 64, LDS_BYTES) != hipSuccess || per_cu < 1) { fprintf(stderr, "kernel_launch: occupancy query reports %d workgroups per CU\n", per_cu); (void)hipGetLastError(); grid = -1; return; }
        grid = cus;
    }
    if (grid < 0) return;
    if (hipMemsetAsync((char*)d_ws + WS_CTL, 0, CTL_ZERO_BYTES, stream) != hipSuccess) { fprintf(stderr, "kernel_launch: hipMemsetAsync failed\n"); return; }
    Args a{};
    for (int i = 0; i < 22; ++i) a.in[i] = (const float*)d_in[i];
    a.out = (float*)d_out; a.ws = (unsigned char*)d_ws;
    if (N_LAUNCHES == 1) {
        a.ph_lo = 0; a.ph_hi = N_PHASES;
        void* kargs[] = {&a};
        const hipError_t le = hipLaunchCooperativeKernel((const void*)mk_fwd, dim3(grid), dim3(NWAVES * 64), kargs, LDS_BYTES, stream);
        if (le != hipSuccess) fprintf(stderr, "kernel_launch: cooperative launch failed: %s (grid %d)\n", hipGetErrorName(le), grid);
    } else {
        for (int li = 0; li < N_PHASES; ++li) {
            a.ph_lo = li; a.ph_hi = li + 1;
            hipLaunchKernelGGL(mk_fwd, dim3(grid), dim3(NWAVES * 64), LDS_BYTES, stream, a);
            const hipError_t le = hipPeekAtLastError();
            if (le != hipSuccess) { fprintf(stderr, "kernel_launch: launch %d failed: %s\n", li, hipGetErrorName(le)); break; }
        }
    }
}
```

```cpp
#include <hip/hip_runtime.h>
#include <cstdio>
#include <cstdint>
#define MK_N_LAUNCHES 1
namespace pg8 {
#define PG8_LAS __attribute__((address_space(3)))
typedef unsigned short bf16_t;
typedef short bf16x8 __attribute__((ext_vector_type(8)));
typedef float f32x4 __attribute__((ext_vector_type(4)));
typedef unsigned u32x4 __attribute__((ext_vector_type(4)));
constexpr int BM = 256, BK = 64, HALF = 128, HTB = HALF * BK * 2  , STAGE_BYTES = 8 * HTB, NXCD = 8, WGM = 8;

__host__ __device__ __forceinline__ int lds_byte(int r, int c) { const int st = (r >> 4) * 2 + (c >> 5), rr = r & 15, cc = c & 31, ob = rr * 64 + cc * 2; return st * 1024 + (ob ^ (((ob >> 9) & 1) << 5)); }
__host__ __device__ __forceinline__ void stage_rc(int b, int& R, int& C) { const int st = b / 1024, sb = b % 1024, swz = sb ^ (((sb >> 9) & 1) << 5); R = (st >> 1) * 16 + swz / 64; C = (st & 1) * 32 + (swz % 64) / 2; }
__host__ __device__ __forceinline__ int perm32(int rho) { const int n = rho >> 4, i = rho & 15; return 8 * (i >> 2) + 4 * n + (i & 3); }

struct Unit { int pm, pn; };
struct Gemm { const bf16_t* A; const bf16_t* Bt; int M, N, K; };

struct StaticOrder {
    int nM, nN, nwg, G, c;
    __host__ __device__ void init(int M, int N, int G_, int c_) { nM = M / BM; nN = N / BM; nwg = nM * nN; G = G_; c = c_; }
    __host__ __device__ bool next(int i, Unit& u) const {
        const long L = (long)i * G + c; if (L >= nwg) return false;
        int wgid = (int)L; { const int q = nwg / NXCD, r = nwg % NXCD, xcd = wgid % NXCD, off = wgid / NXCD; wgid = (xcd < r ? xcd * (q + 1) : r * (q + 1) + (xcd - r) * q) + off; }
        const int nig = WGM * nN, gid = wgid / nig, fm = gid * WGM, gsz = (nM - fm) < WGM ? (nM - fm) : WGM;
        u.pm = fm + ((wgid % nig) % gsz); u.pn = (wgid % nig) / gsz; return true;
    }
    __device__ __forceinline__ void a_ready(const Unit&) const {}
    __device__ __forceinline__ void done(const Unit&) const {}
};

struct OneUnit {
    int pm, pn;
    __device__ __forceinline__ bool next(int i, Unit& u) const { if (i != 0) return false; u.pm = pm; u.pn = pn; return true; }
    __device__ __forceinline__ void a_ready(const Unit&) const {}
    __device__ __forceinline__ void done(const Unit&) const {}
};

__device__ __forceinline__ unsigned cvt_pk_bf16(float lo, float hi) { unsigned r; asm volatile("v_cvt_pk_bf16_f32 %0, %1, %2" : "=v"(r) : "v"(lo), "v"(hi)); return r; }
__device__ __forceinline__ float bf_lo(unsigned w) { return __uint_as_float(w << 16); }
__device__ __forceinline__ float bf_hi(unsigned w) { return __uint_as_float(w & 0xffff0000u); }
__device__ __forceinline__ float sigm(float x) { return __builtin_amdgcn_rcpf(1.0f + __expf(-x)); }
__device__ __forceinline__ float gelu_tanh(float x) { const float z = 1.5957691216f * (x + 0.044715f * x * x * x); return x * sigm(z); }
__device__ __forceinline__ u32x4 pack8(const f32x4 v0, const f32x4 v1) { u32x4 w; w.x = cvt_pk_bf16(v0[0], v0[1]); w.y = cvt_pk_bf16(v0[2], v0[3]); w.z = cvt_pk_bf16(v1[0], v1[1]); w.w = cvt_pk_bf16(v1[2], v1[3]); return w; }

struct EpiInMain {
    static constexpr bool PERM = true, AFTER_DRAIN = false;
    bf16_t* UX; bf16_t* UY; bf16_t* UG; bf16_t* PQ;
    __device__ __forceinline__ void operator()(const f32x4 (&acc)[2][2][4][2], const Unit& u, int wr, int wc, int fr, int fq) const {
        const int row0 = u.pm * BM + wr * 64 + fr; const int ct = u.pn * BM;
        bf16_t* base; int ldc, colt, act;
        if (ct < 1024) { base = UX; ldc = 1024; colt = ct; act = 0; }
        else if (ct < 2048) { base = UY; ldc = 1024; colt = ct - 1024; act = 1; }
        else if (ct < 4096) { base = UG; ldc = 2048; colt = ct - 2048; act = 2; }
        else { base = PQ; ldc = 1024; colt = ct - 4096; act = 0; }
        const int col0 = colt + wc * 32 + 8 * fq;
#pragma unroll
        for (int ai = 0; ai < 2; ++ai)
#pragma unroll
            for (int m = 0; m < 4; ++m) { bf16_t* rowp = base + (size_t)(row0 + ai * HALF + m * 16) * ldc + col0;
#pragma unroll
                for (int bj = 0; bj < 2; ++bj) { f32x4 v0 = acc[ai][bj][m][0], v1 = acc[ai][bj][m][1];
                    if (act == 1) {
#pragma unroll
                        for (int j = 0; j < 4; ++j) { v0[j] = gelu_tanh(v0[j]); v1[j] = gelu_tanh(v1[j]); } }
                    if (act == 2) {
#pragma unroll
                        for (int j = 0; j < 4; ++j) { v0[j] = sigm(v0[j]); v1[j] = sigm(v1[j]); } }
                    *(u32x4*)(rowp + bj * HALF) = pack8(v0, v1); } }
    }
};
template <int ACT  > struct EpiBf16 {
    static constexpr bool PERM = true, AFTER_DRAIN = false;
    bf16_t* O; int ldc;
    __device__ __forceinline__ void operator()(const f32x4 (&acc)[2][2][4][2], const Unit& u, int wr, int wc, int fr, int fq) const {
        const int row0 = u.pm * BM + wr * 64 + fr; const int col0 = u.pn * BM + wc * 32 + 8 * fq;
#pragma unroll
        for (int ai = 0; ai < 2; ++ai)
#pragma unroll
            for (int m = 0; m < 4; ++m) { bf16_t* rowp = O + (size_t)(row0 + ai * HALF + m * 16) * ldc + col0;
#pragma unroll
                for (int bj = 0; bj < 2; ++bj) { f32x4 v0 = acc[ai][bj][m][0], v1 = acc[ai][bj][m][1];
                    if (ACT == 1) {
#pragma unroll
                        for (int j = 0; j < 4; ++j) { const float a = fmaxf(v0[j], 0.f), b = fmaxf(v1[j], 0.f); v0[j] = a * a; v1[j] = b * b; } }
                    *(u32x4*)(rowp + bj * HALF) = pack8(v0, v1); } }
    }
};
struct EpiPQT {
    static constexpr bool PERM = true, AFTER_DRAIN = false;
    bf16_t* PQT;
    __device__ __forceinline__ void operator()(const f32x4 (&acc)[2][2][4][2], const Unit& u, int wr, int wc, int fr, int fq) const {
        const int row0 = u.pm * BM + wr * 64 + fr; const int col0 = u.pn * BM + wc * 32 + 8 * fq;
#pragma unroll
        for (int ai = 0; ai < 2; ++ai)
#pragma unroll
            for (int m = 0; m < 4; ++m) { const int row = row0 + ai * HALF + m * 16; const int pq = row >> 9, j = row & 511;
#pragma unroll
                for (int bj = 0; bj < 2; ++bj) { const int col = col0 + bj * HALF; const int b = col >> 11, t = col & 2047;
                    bf16_t* p = PQT + (((size_t)(b * 512 + j) * 2 + pq) * 2048 + t);
                    *(u32x4*)p = pack8(acc[ai][bj][m][0], acc[ai][bj][m][1]); } }
    }
};
struct EpiDft {
    static constexpr bool PERM = true, AFTER_DRAIN = false;
    bf16_t* YF;
    __device__ __forceinline__ void operator()(const f32x4 (&acc)[2][2][4][2], const Unit& u, int wr, int wc, int fr, int fq) const {
        const int row0 = u.pm * BM + wr * 64 + fr; const int col0 = u.pn * BM + wc * 32 + 8 * fq;
#pragma unroll
        for (int ai = 0; ai < 2; ++ai)
#pragma unroll
            for (int m = 0; m < 4; ++m) { const int k = row0 + ai * HALF + m * 16;
#pragma unroll
                for (int bj = 0; bj < 2; ++bj) { const int col = col0 + bj * HALF; const int b = col >> 9, j = col & 511;
                    bf16_t* p = YF + ((size_t)(b * 2048 + k) * 512 + j);
                    *(u32x4*)p = pack8(acc[ai][bj][m][0], acc[ai][bj][m][1]); } }
    }
};
template <bool HAS_ADD> struct EpiGate {
    static constexpr bool PERM = true, AFTER_DRAIN = false;
    bf16_t* O; int ldc; const bf16_t* G; int ldg; const bf16_t* ADD;
    __device__ __forceinline__ void operator()(const f32x4 (&acc)[2][2][4][2], const Unit& u, int wr, int wc, int fr, int fq) const {
        const int row0 = u.pm * BM + wr * 64 + fr; const int col0 = u.pn * BM + wc * 32 + 8 * fq;
#pragma unroll
        for (int ai = 0; ai < 2; ++ai)
#pragma unroll
            for (int m = 0; m < 4; ++m) { const size_t row = (size_t)(row0 + ai * HALF + m * 16);
#pragma unroll
                for (int bj = 0; bj < 2; ++bj) { const int col = col0 + bj * HALF;
                    const u32x4 g = *(const u32x4*)(G + row * ldg + col);
                    f32x4 v0 = acc[ai][bj][m][0], v1 = acc[ai][bj][m][1];
                    v0[0] *= bf_lo(g.x); v0[1] *= bf_hi(g.x); v0[2] *= bf_lo(g.y); v0[3] *= bf_hi(g.y);
                    v1[0] *= bf_lo(g.z); v1[1] *= bf_hi(g.z); v1[2] *= bf_lo(g.w); v1[3] *= bf_hi(g.w);
                    if (HAS_ADD) { const u32x4 a = *(const u32x4*)(ADD + row * ldc + col);
                        v0[0] += bf_lo(a.x); v0[1] += bf_hi(a.x); v0[2] += bf_lo(a.y); v0[3] += bf_hi(a.y);
                        v1[0] += bf_lo(a.z); v1[1] += bf_hi(a.z); v1[2] += bf_lo(a.w); v1[3] += bf_hi(a.w); }
                    *(u32x4*)(O + row * ldc + col) = pack8(v0, v1); } }
    }
};
template <int MODE> struct EpiResid {
    static constexpr bool PERM = false, AFTER_DRAIN = false;
    const float* X; float* O; const float* gate  ; const float* pos  ;
    __device__ __forceinline__ void operator()(const f32x4 (&acc)[2][2][4][2], const Unit& u, int wr, int wc, int fr, int fq) const {
        const int row0 = u.pm * BM + wr * 64 + fr, col0 = u.pn * BM + wc * 32 + 4 * fq;
#pragma unroll
        for (int ai = 0; ai < 2; ++ai)
#pragma unroll
            for (int m = 0; m < 4; ++m) { const int row = row0 + ai * HALF + m * 16; const int b = row >> 11, t = row & 2047;
#pragma unroll
                for (int bj = 0; bj < 2; ++bj)
#pragma unroll
                    for (int n = 0; n < 2; ++n) { const int c = col0 + bj * HALF + n * 16;
                        const f32x4 gt = *(const f32x4*)(gate + (size_t)b * 6144 + c);
                        f32x4 base;
                        if (MODE == 0) { const f32x4 pv = (c < 512) ? *(const f32x4*)(pos + (t >> 6) * 512 + c) : *(const f32x4*)(pos + 32 * 512 + (t & 63) * 512 + (c - 512));
                            base = *(const f32x4*)(X + (size_t)row * 1024 + c) + pv; }
                        else base = *(const f32x4*)(O + (size_t)row * 1024 + c);
                        *(f32x4*)(O + (size_t)row * 1024 + c) = base + gt * acc[ai][bj][m][n]; }
                asm volatile("" ::: "memory"); }
    }
};

template <class Epi, class Sched, bool ALIGN_EPI = false, bool SP2 = false>
__device__ __forceinline__ void gemm_phase(PG8_LAS unsigned char* lds, const Gemm g, const Sched& S, const Epi& E) {
    const int tid = threadIdx.x, wid = __builtin_amdgcn_readfirstlane(tid >> 6), lane = tid & 63, wr = wid >> 2, wc = wid & 3, fr = lane & 15, fq = lane >> 4;
    const int K = g.K, nt = K / BK;
    unsigned voffA[2], voffB[2];
#pragma unroll
    for (int i = 0; i < 2; ++i) { int R, C; stage_rc(tid * 16 + i * 8192, R, C); const int Rb = Epi::PERM ? ((R & ~31) + perm32(R & 31)) : R;
        voffA[i] = (unsigned)(R * K + C) * 2u; voffB[i] = (unsigned)(Rb * K + C) * 2u; }
    const size_t kstep = (size_t)(BK * 2);
    const size_t hstep = (size_t)HALF * K * 2;
    const size_t tstep = 2 * hstep;
    const unsigned ldsw = (unsigned)wid * 1024u;
    const int aoff = lds_byte(wr * 64 + fr, fq * 8), boff = lds_byte(wc * 32 + fr, fq * 8);
#define PG8_SA(b, h) (((b) * 2 + (h)) * HTB)
#define PG8_SB(b, h) ((4 + (b) * 2 + (h)) * HTB)
#define PG8_STAGE(bufoff, gbase, voff) do { _Pragma("unroll") for (int _i = 0; _i < 2; ++_i) \
        __builtin_amdgcn_global_load_lds((const unsigned*)((const char*)(gbase) + (voff)[_i]), (PG8_LAS unsigned*)(lds + (bufoff) + ldsw + _i * 8192), 16, 0, 0); } while (0)
#define PG8_LDA(dst, b, h) do { _Pragma("unroll") for (int m = 0; m < 4; ++m) _Pragma("unroll") for (int k = 0; k < 2; ++k) dst[m][k] = *(const PG8_LAS bf16x8*)(lds + PG8_SA(b, h) + aoff + m * 2048 + k * 1024); } while (0)
#define PG8_LDB(dst, b, h) do { _Pragma("unroll") for (int n = 0; n < 2; ++n) _Pragma("unroll") for (int k = 0; k < 2; ++k) dst[n][k] = *(const PG8_LAS bf16x8*)(lds + PG8_SB(b, h) + boff + n * 2048 + k * 1024); } while (0)
#define PG8_MMA(ai, bj, At, Bt) do { __builtin_amdgcn_s_setprio(1); _Pragma("unroll") for (int m = 0; m < 4; ++m) _Pragma("unroll") for (int n = 0; n < 2; ++n) _Pragma("unroll") for (int k = 0; k < 2; ++k) \
        acc[ai][bj][m][n] = __builtin_amdgcn_mfma_f32_16x16x32_bf16(Bt[n][k], At[m][k], acc[ai][bj][m][n], 0, 0, 0); __builtin_amdgcn_s_setprio(0); } while (0)
#define PG8_WAIT_V(n) asm volatile("s_waitcnt vmcnt(" #n ")" ::: "memory")
#define PG8_WAIT_L(n) asm volatile("s_waitcnt lgkmcnt(" #n ")" ::: "memory")
#define PG8_BAR __builtin_amdgcn_s_barrier()
#define PG8_SCHED __builtin_amdgcn_sched_barrier(0)
    Unit cur, nxt; int ui = 0;
    if (!S.next(0, cur)) return;
    f32x4 acc[2][2][4][2];
#pragma unroll
    for (int a = 0; a < 2; ++a)
#pragma unroll
        for (int b = 0; b < 2; ++b)
#pragma unroll
            for (int m = 0; m < 4; ++m)
#pragma unroll
                for (int n = 0; n < 2; ++n) acc[a][b][m][n] = (f32x4){0.f, 0.f, 0.f, 0.f};
    bf16x8 At[4][2], B0[2][2], B1[2][2];
    const char* cA = (const char*)g.A + (size_t)cur.pm * tstep; const char* cB = (const char*)g.Bt + (size_t)cur.pn * tstep;
    S.a_ready(cur);
    if constexpr (SP2) {
        PG8_STAGE(PG8_SB(0, 0), cB, voffB); PG8_STAGE(PG8_SB(0, 1), cB + hstep, voffB); PG8_STAGE(PG8_SA(0, 0), cA, voffA); PG8_STAGE(PG8_SA(0, 1), cA + hstep, voffA);
        if (wr == 1) PG8_BAR;
        PG8_WAIT_V(2); PG8_BAR;
        PG8_STAGE(PG8_SB(1, 0), cB + kstep, voffB); PG8_STAGE(PG8_SA(1, 0), cA + kstep, voffA); PG8_STAGE(PG8_SB(1, 1), cB + hstep + kstep, voffB);
        PG8_WAIT_V(6); PG8_BAR;
    } else {
        PG8_STAGE(PG8_SB(0, 0), cB, voffB); PG8_STAGE(PG8_SA(0, 0), cA, voffA); PG8_STAGE(PG8_SB(0, 1), cB + hstep, voffB); PG8_STAGE(PG8_SA(0, 1), cA + hstep, voffA);
        if (wr == 1) PG8_BAR;
        PG8_WAIT_V(4); PG8_BAR;
        PG8_STAGE(PG8_SB(1, 0), cB + kstep, voffB); PG8_STAGE(PG8_SA(1, 0), cA + kstep, voffA); PG8_STAGE(PG8_SB(1, 1), cB + hstep + kstep, voffB);
        PG8_WAIT_V(6); PG8_BAR;
    }
    for (;;) {
        const bool has_next = S.next(ui + 1, nxt);
        const char* nA = has_next ? (const char*)g.A + (size_t)nxt.pm * tstep : cA; const char* nB = has_next ? (const char*)g.Bt + (size_t)nxt.pn * tstep : cB;
        for (int t = 0; t < nt; t += 2) {
            const bool last = (t == nt - 2);
            const char* a1 = cA + (size_t)(t + 1) * kstep;
            const char* a2 = last ? nA : cA + (size_t)(t + 2) * kstep; const char* b2 = last ? nB : cB + (size_t)(t + 2) * kstep;
            const char* a3 = a2 + kstep; const char* b3 = b2 + kstep;
            if (last && has_next) S.a_ready(nxt);
            if constexpr (SP2) {
            PG8_LDB(B0, 0, 0); PG8_LDB(B1, 0, 1); PG8_SCHED; PG8_LDA(At, 0, 0); PG8_STAGE(PG8_SA(1, 1), a1 + hstep, voffA);
            PG8_WAIT_V(8); PG8_WAIT_L(0); PG8_BAR; PG8_MMA(0, 0, At, B0); PG8_MMA(0, 1, At, B1); PG8_BAR; PG8_SCHED;
            PG8_LDA(At, 0, 1); PG8_STAGE(PG8_SB(0, 0), b2, voffB); PG8_STAGE(PG8_SB(0, 1), b2 + hstep, voffB); PG8_STAGE(PG8_SA(0, 0), a2, voffA);
            PG8_WAIT_V(8); PG8_WAIT_L(0); PG8_BAR; PG8_MMA(1, 0, At, B0); PG8_MMA(1, 1, At, B1); PG8_BAR; PG8_SCHED;
            PG8_LDB(B0, 1, 0); PG8_LDB(B1, 1, 1); PG8_SCHED; PG8_LDA(At, 1, 0); PG8_STAGE(PG8_SA(0, 1), a2 + hstep, voffA);
            PG8_WAIT_V(8); PG8_WAIT_L(0); PG8_BAR; PG8_MMA(0, 0, At, B0); PG8_MMA(0, 1, At, B1); PG8_BAR; PG8_SCHED;
            PG8_LDA(At, 1, 1); PG8_STAGE(PG8_SB(1, 0), b3, voffB); PG8_STAGE(PG8_SB(1, 1), b3 + hstep, voffB); PG8_STAGE(PG8_SA(1, 0), a3, voffA);
            PG8_WAIT_V(8); PG8_WAIT_L(0); PG8_BAR; PG8_MMA(1, 0, At, B0); PG8_MMA(1, 1, At, B1); PG8_BAR; PG8_SCHED;
            } else {
            PG8_LDB(B0, 0, 0); PG8_SCHED; PG8_LDA(At, 0, 0); PG8_STAGE(PG8_SA(1, 1), a1 + hstep, voffA);
            PG8_WAIT_L(8); PG8_BAR; PG8_WAIT_L(0); PG8_MMA(0, 0, At, B0); PG8_BAR; PG8_SCHED;
            PG8_LDB(B1, 0, 1); PG8_STAGE(PG8_SB(0, 0), b2, voffB);
            PG8_BAR; PG8_WAIT_L(0); PG8_MMA(0, 1, At, B1); PG8_BAR;
            PG8_LDA(At, 0, 1); PG8_STAGE(PG8_SA(0, 0), a2, voffA);
            PG8_BAR; PG8_WAIT_L(0); PG8_MMA(1, 0, At, B0); PG8_BAR; PG8_SCHED;
            PG8_STAGE(PG8_SB(0, 1), b2 + hstep, voffB);
            PG8_WAIT_V(6); PG8_BAR; PG8_MMA(1, 1, At, B1); PG8_BAR;
            PG8_LDB(B0, 1, 0); PG8_SCHED; PG8_LDA(At, 1, 0); PG8_STAGE(PG8_SA(0, 1), a2 + hstep, voffA);
            PG8_WAIT_L(8); PG8_BAR; PG8_WAIT_L(0); PG8_MMA(0, 0, At, B0); PG8_BAR; PG8_SCHED;
            PG8_LDB(B1, 1, 1); PG8_STAGE(PG8_SB(1, 0), b3, voffB);
            PG8_BAR; PG8_WAIT_L(0); PG8_MMA(0, 1, At, B1); PG8_BAR;
            PG8_LDA(At, 1, 1); PG8_STAGE(PG8_SA(1, 0), a3, voffA);
            PG8_BAR; PG8_WAIT_L(0); PG8_MMA(1, 0, At, B0); PG8_BAR; PG8_SCHED;
            PG8_STAGE(PG8_SB(1, 1), b3 + hstep, voffB);
            PG8_WAIT_V(6); PG8_BAR; PG8_MMA(1, 1, At, B1); PG8_BAR;
            }
        }
        if constexpr (ALIGN_EPI) { if (wr == 0) PG8_BAR; }
        if constexpr (!Epi::AFTER_DRAIN) { E(acc, cur, wr, wc, fr, fq); S.done(cur); }
        if (!has_next) break;
#pragma unroll
        for (int a = 0; a < 2; ++a)
#pragma unroll
            for (int b = 0; b < 2; ++b)
#pragma unroll
                for (int m = 0; m < 4; ++m)
#pragma unroll
                    for (int n = 0; n < 2; ++n) acc[a][b][m][n] = (f32x4){0.f, 0.f, 0.f, 0.f};
        cur = nxt; cA = nA; cB = nB; ++ui;
        if constexpr (ALIGN_EPI) { if (wr == 1) PG8_BAR; }
    }
    PG8_WAIT_V(0);
    if constexpr (!ALIGN_EPI) { if (wr == 0) PG8_BAR; }
    PG8_BAR;
    if constexpr (Epi::AFTER_DRAIN) { E.fused(acc, cur, wr, wc, fr, fq, lds, wid, lane); S.done(cur); }
#undef PG8_SA
#undef PG8_SB
#undef PG8_STAGE
#undef PG8_LDA
#undef PG8_LDB
#undef PG8_MMA
#undef PG8_WAIT_V
#undef PG8_WAIT_L
#undef PG8_BAR
#undef PG8_SCHED
}
}
#define PG8_SP2 true

constexpr int NWAVES = 8;
#ifndef MK_N_LAUNCHES
#define MK_N_LAUNCHES 1
#endif
constexpr int N_PHASES = 12;
constexpr int N_LAUNCHES = MK_N_LAUNCHES;

constexpr int NB = 8, T = 2048, D = 1024, M = NB * T, CT = 256, MC = NB * CT, FW = 512, FF = 4096, NMOD = 6 * D;
constexpr float EPS = 1e-6f;

constexpr size_t MiB = 1u << 20;
constexpr size_t WS_CTL = 0, CTL_ZERO_BYTES = 64 * 1024;
constexpr size_t WS_MODF = 1 * MiB;
constexpr size_t WS_POS = 1 * MiB + 256 * 1024;
constexpr size_t WS_WIN = 2 * MiB;
constexpr size_t WS_W1 = 12 * MiB, WS_W2 = 20 * MiB, WS_WOUT = 28 * MiB, WS_WL = 30 * MiB, WS_WF = 32 * MiB, WS_WG = 33 * MiB;
constexpr size_t WS_HCTX = 34 * MiB, WS_UXC = 38 * MiB;
constexpr size_t WS_HLAT = 48 * MiB;
constexpr size_t WS_UX = 80 * MiB;
constexpr size_t WS_PQT = 112 * MiB;
constexpr size_t WS_YF = 144 * MiB;
constexpr size_t WS_DFTM = 160 * MiB;
constexpr size_t WS_HID = 48 * MiB;
constexpr size_t WS_UY = 176 * MiB;
constexpr size_t WS_YB = 208 * MiB;
constexpr size_t WS_END = 240 * MiB;
constexpr int CW_BAR = 1024;

constexpr int RING_OFF = 0, RING_BYTES = 131072;
constexpr int LDSCTL_OFF = RING_BYTES, MISC_OFF = LDSCTL_OFF + 320;
constexpr int LDS_BYTES = 147456;
static_assert(MISC_OFF + 128 <= LDS_BYTES, "LDS map");

#define GAS __attribute__((address_space(1)))
#define LAS __attribute__((address_space(3)))
typedef unsigned short bf16;
typedef unsigned v4u __attribute__((ext_vector_type(4)));
typedef unsigned v2u __attribute__((ext_vector_type(2)));
typedef float f32x4 __attribute__((ext_vector_type(4)));
typedef float f32x16 __attribute__((ext_vector_type(16)));
typedef short bf16x8 __attribute__((ext_vector_type(8)));
typedef GAS unsigned gu32;
#define RLX_AGENT __ATOMIC_RELAXED, __HIP_MEMORY_SCOPE_AGENT
#define LDS_WAIT() asm volatile("s_waitcnt lgkmcnt(0)" ::: "memory")
#define VM_WAIT() asm volatile("s_waitcnt vmcnt(0)" ::: "memory")
#define CBAR() asm volatile("" ::: "memory")
__device__ __forceinline__ unsigned f2bf(float f) { unsigned u = __builtin_bit_cast(unsigned, f); return (u + 0x7fffu + ((u >> 16) & 1u)) >> 16; }
__device__ __forceinline__ unsigned pk2(float lo, float hi) { return f2bf(lo) | (f2bf(hi) << 16); }
__device__ __forceinline__ float bflo(unsigned w) { return __uint_as_float(w << 16); }
__device__ __forceinline__ float bfhi(unsigned w) { return __uint_as_float(w & 0xffff0000u); }
__device__ __forceinline__ float bf1(unsigned short h) { return __uint_as_float(((unsigned)h) << 16); }

#define XB_TMO      128
#define XB_XCNT(j)  (256  + 64 * (j))
#define XB_XSUB(j)  (1280 + 64 * (j))
#define XB_XGEN(j)  (2304 + 64 * (j))
#define XB_TOP      3328
#define XB_TOPGEN   3392
#define XCD_BAR_WORDS 3456
#define XB_SPIN_CAP (1u << 18)

__device__ __forceinline__ unsigned xb_ld(unsigned* p)              { return __hip_atomic_load(p, __ATOMIC_RELAXED, __HIP_MEMORY_SCOPE_AGENT); }
__device__ __forceinline__ unsigned xb_add(unsigned* p, unsigned v) { return __hip_atomic_fetch_add(p, v, __ATOMIC_RELAXED, __HIP_MEMORY_SCOPE_AGENT); }
__device__ __forceinline__ unsigned xb_xcc_id() { return (unsigned)__builtin_amdgcn_s_getreg((3 << 11) | 20) & 0xFu; }
#define XB_SPIN(cond, bar) do { unsigned _sp = 0; while (cond) { __builtin_amdgcn_s_sleep(1); \
    if ((++_sp & 255u) == 0u) { if (xb_ld(&(bar)[XB_TMO])) break; if (_sp > XB_SPIN_CAP) { atomicAdd(&(bar)[XB_TMO], 1u); break; } } } } while (0)

struct XcdBarrier {
    unsigned* bar; unsigned x;
    volatile LAS unsigned* st;
};

__device__ __forceinline__ XcdBarrier xcd_barrier_post(unsigned* bar, volatile LAS unsigned* st) {
    XcdBarrier b; b.bar = bar; b.x = xb_xcc_id(); b.st = st;
    if (threadIdx.x == 0) (void)xb_add(&bar[XB_XCNT(b.x)], 1u);
    return b;
}
__device__ __forceinline__ void xcd_barrier_complete(unsigned* bar, unsigned x, unsigned& nloc, unsigned& nx) {
    const unsigned G = gridDim.x * gridDim.y * gridDim.z;
    unsigned sum, cnt, mine, sp = 0u;
    for (;;) {
        sum = 0u; cnt = 0u; mine = 0u;
#pragma unroll
        for (unsigned j = 0; j < 16; ++j) { const unsigned c = xb_ld(&bar[XB_XCNT(j)]); sum += c; cnt += (c > 0u) ? 1u : 0u; mine = (j == x) ? c : mine; }
        if (sum == G) break;
        __builtin_amdgcn_s_sleep(1);
        if ((++sp & 255u) == 0u) { if (xb_ld(&bar[XB_TMO])) break; if (sp > XB_SPIN_CAP) { atomicAdd(&bar[XB_TMO], 1u); break; } }
    }
    nloc = mine > 0u ? mine : 1u; nx = cnt > 0u ? cnt : 1u;
}

__device__ __forceinline__ void xcd_barrier(const XcdBarrier& b) {
    asm volatile("s_waitcnt vmcnt(0)" ::: "memory");
    __syncthreads();
    if (threadIdx.x == 0) {
        unsigned* bar = b.bar;
        __builtin_amdgcn_s_waitcnt(0);
        unsigned nloc = b.st[0], nx = b.st[1];
        if (nloc == 0u) { xcd_barrier_complete(bar, b.x, nloc, nx); b.st[0] = nloc; b.st[1] = nx; }
        const unsigned old = xb_add(&bar[XB_XSUB(b.x)], 1u);
        const unsigned gen = old / nloc;
        if (old + 1u == (gen + 1u) * nloc) {
            __builtin_amdgcn_fence(__ATOMIC_RELEASE, "agent");
            asm volatile("s_waitcnt vmcnt(0)" ::: "memory");
            const unsigned og = xb_add(&bar[XB_TOP], 1u);
            const unsigned tg = og / nx;
            if (og + 1u == (tg + 1u) * nx) xb_add(&bar[XB_TOPGEN], 1u);
            else XB_SPIN(xb_ld(&bar[XB_TOPGEN]) == tg, bar);
            __builtin_amdgcn_fence(__ATOMIC_ACQUIRE, "agent");
            xb_add(&bar[XB_XGEN(b.x)], 1u);
            asm volatile("s_waitcnt vmcnt(0)" ::: "memory");
        } else {
            XB_SPIN(xb_ld(&bar[XB_XGEN(b.x)]) == gen, bar);
            __builtin_amdgcn_fence(__ATOMIC_ACQUIRE, "agent");
            asm volatile("s_waitcnt vmcnt(0)" ::: "memory");
        }
    }
    __syncthreads();
}

struct Frame {
    LAS unsigned char* lds;
    volatile LAS unsigned* MISC;
    gu32* ctl;
    int tid, lane, wave;
    int vcu, G;
    const float *x, *c, *ctx, *c_ctx, *w_mod, *b_mod, *g_mix, *w_in, *conv_w, *conv_b, *w_a, *b_a, *w_x, *b_x, *lam, *w_lru_out, *w_f_out, *w_out, *g_mlp, *w1, *w2, *g_final;
    float* out;
    float *MODF, *POS;
    bf16 *WIN, *W1T, *W2T, *WOUT, *WL, *WF, *WG, *HCTX, *UXC, *HLAT, *UX, *YF, *PQ, *HID, *UY, *YB, *UG, *XC, *XCC, *XNC;
};

__device__ __forceinline__ float wave_sum(float v) {
#pragma unroll
    for (int o = 1; o < 64; o <<= 1) v += __shfl_xor(v, o);
    return v;
}
__device__ __forceinline__ float sigm(float x) { return __builtin_amdgcn_rcpf(1.0f + __expf(-x)); }

__device__ __forceinline__ void p0_transpose_item(const float* W, int K, int ldw, int col0, int nblk, bf16* WT, int row_off, LAS float* scr, int item, int lane) {
    const int kb = item / nblk, nb = item % nblk, k0 = 64 * kb, n0 = 32 * nb;
    float tv[32];
#pragma unroll
    for (int i = 0; i < 32; ++i) { const int kk = 2 * i + (lane >> 5); tv[i] = W[(size_t)(k0 + kk) * ldw + col0 + n0 + (lane & 31)]; }
#pragma unroll
    for (int i = 0; i < 32; ++i) { const int kk = 2 * i + (lane >> 5); scr[kk * 33 + (lane & 31)] = tv[i]; }
    LDS_WAIT(); CBAR();
    const int c = lane & 7;
#pragma unroll
    for (int j = 0; j < 4; ++j) { const int n = (lane >> 3) + 8 * j; const LAS float* s = scr + (8 * c) * 33 + n;
        v4u o; o.x = pk2(s[0 * 33], s[1 * 33]); o.y = pk2(s[2 * 33], s[3 * 33]); o.z = pk2(s[4 * 33], s[5 * 33]); o.w = pk2(s[6 * 33], s[7 * 33]);
        *(v4u*)(WT + (size_t)(row_off + n0 + n) * K + k0 + 8 * c) = o; }
    LDS_WAIT(); CBAR();
}

__constant__ float c_trig128[256] = { 1.000000000e+00f, 9.987954562e-01f, 9.951847267e-01f, 9.891765100e-01f, 9.807852804e-01f, 9.700312532e-01f, 9.569403357e-01f, 9.415440652e-01f, 9.238795325e-01f, 9.039892931e-01f, 8.819212643e-01f, 8.577286100e-01f, 8.314696123e-01f, 8.032075315e-01f, 7.730104534e-01f, 7.409511254e-01f, 7.071067812e-01f, 6.715589548e-01f, 6.343932842e-01f, 5.956993045e-01f, 5.555702330e-01f, 5.141027442e-01f, 4.713967368e-01f, 4.275550934e-01f, 3.826834324e-01f, 3.368898534e-01f, 2.902846773e-01f, 2.429801799e-01f, 1.950903220e-01f, 1.467304745e-01f, 9.801714033e-02f, 4.906767433e-02f, 6.123233996e-17f, -4.906767433e-02f, -9.801714033e-02f, -1.467304745e-01f, -1.950903220e-01f, -2.429801799e-01f, -2.902846773e-01f, -3.368898534e-01f, -3.826834324e-01f, -4.275550934e-01f, -4.713967368e-01f, -5.141027442e-01f, -5.555702330e-01f, -5.956993045e-01f, -6.343932842e-01f, -6.715589548e-01f, -7.071067812e-01f, -7.409511254e-01f, -7.730104534e-01f, -8.032075315e-01f, -8.314696123e-01f, -8.577286100e-01f, -8.819212643e-01f, -9.039892931e-01f, -9.238795325e-01f, -9.415440652e-01f, -9.569403357e-01f, -9.700312532e-01f, -9.807852804e-01f, -9.891765100e-01f, -9.951847267e-01f, -9.987954562e-01f, -1.000000000e+00f, -9.987954562e-01f, -9.951847267e-01f, -9.891765100e-01f, -9.807852804e-01f, -9.700312532e-01f, -9.569403357e-01f, -9.415440652e-01f, -9.238795325e-01f, -9.039892931e-01f, -8.819212643e-01f, -8.577286100e-01f, -8.314696123e-01f, -8.032075315e-01f, -7.730104534e-01f, -7.409511254e-01f, -7.071067812e-01f, -6.715589548e-01f, -6.343932842e-01f, -5.956993045e-01f, -5.555702330e-01f, -5.141027442e-01f, -4.713967368e-01f, -4.275550934e-01f, -3.826834324e-01f, -3.368898534e-01f, -2.902846773e-01f, -2.429801799e-01f, -1.950903220e-01f, -1.467304745e-01f, -9.801714033e-02f, -4.906767433e-02f, -1.836970199e-16f, 4.906767433e-02f, 9.801714033e-02f, 1.467304745e-01f, 1.950903220e-01f, 2.429801799e-01f, 2.902846773e-01f, 3.368898534e-01f, 3.826834324e-01f, 4.275550934e-01f, 4.713967368e-01f, 5.141027442e-01f, 5.555702330e-01f, 5.956993045e-01f, 6.343932842e-01f, 6.715589548e-01f, 7.071067812e-01f, 7.409511254e-01f, 7.730104534e-01f, 8.032075315e-01f, 8.314696123e-01f, 8.577286100e-01f, 8.819212643e-01f, 9.039892931e-01f, 9.238795325e-01f, 9.415440652e-01f, 9.569403357e-01f, 9.700312532e-01f, 9.807852804e-01f, 9.891765100e-01f, 9.951847267e-01f, 9.987954562e-01f,
    0.000000000e+00f, 4.906767433e-02f, 9.801714033e-02f, 1.467304745e-01f, 1.950903220e-01f, 2.429801799e-01f, 2.902846773e-01f, 3.368898534e-01f, 3.826834324e-01f, 4.275550934e-01f, 4.713967368e-01f, 5.141027442e-01f, 5.555702330e-01f, 5.956993045e-01f, 6.343932842e-01f, 6.715589548e-01f, 7.071067812e-01f, 7.409511254e-01f, 7.730104534e-01f, 8.032075315e-01f, 8.314696123e-01f, 8.577286100e-01f, 8.819212643e-01f, 9.039892931e-01f, 9.238795325e-01f, 9.415440652e-01f, 9.569403357e-01f, 9.700312532e-01f, 9.807852804e-01f, 9.891765100e-01f, 9.951847267e-01f, 9.987954562e-01f, 1.000000000e+00f, 9.987954562e-01f, 9.951847267e-01f, 9.891765100e-01f, 9.807852804e-01f, 9.700312532e-01f, 9.569403357e-01f, 9.415440652e-01f, 9.238795325e-01f, 9.039892931e-01f, 8.819212643e-01f, 8.577286100e-01f, 8.314696123e-01f, 8.032075315e-01f, 7.730104534e-01f, 7.409511254e-01f, 7.071067812e-01f, 6.715589548e-01f, 6.343932842e-01f, 5.956993045e-01f, 5.555702330e-01f, 5.141027442e-01f, 4.713967368e-01f, 4.275550934e-01f, 3.826834324e-01f, 3.368898534e-01f, 2.902846773e-01f, 2.429801799e-01f, 1.950903220e-01f, 1.467304745e-01f, 9.801714033e-02f, 4.906767433e-02f, 1.224646799e-16f, -4.906767433e-02f, -9.801714033e-02f, -1.467304745e-01f, -1.950903220e-01f, -2.429801799e-01f, -2.902846773e-01f, -3.368898534e-01f, -3.826834324e-01f, -4.275550934e-01f, -4.713967368e-01f, -5.141027442e-01f, -5.555702330e-01f, -5.956993045e-01f, -6.343932842e-01f, -6.715589548e-01f, -7.071067812e-01f, -7.409511254e-01f, -7.730104534e-01f, -8.032075315e-01f, -8.314696123e-01f, -8.577286100e-01f, -8.819212643e-01f, -9.039892931e-01f, -9.238795325e-01f, -9.415440652e-01f, -9.569403357e-01f, -9.700312532e-01f, -9.807852804e-01f, -9.891765100e-01f, -9.951847267e-01f, -9.987954562e-01f, -1.000000000e+00f, -9.987954562e-01f, -9.951847267e-01f, -9.891765100e-01f, -9.807852804e-01f, -9.700312532e-01f, -9.569403357e-01f, -9.415440652e-01f, -9.238795325e-01f, -9.039892931e-01f, -8.819212643e-01f, -8.577286100e-01f, -8.314696123e-01f, -8.032075315e-01f, -7.730104534e-01f, -7.409511254e-01f, -7.071067812e-01f, -6.715589548e-01f, -6.343932842e-01f, -5.956993045e-01f, -5.555702330e-01f, -5.141027442e-01f, -4.713967368e-01f, -4.275550934e-01f, -3.826834324e-01f, -3.368898534e-01f, -2.902846773e-01f, -2.429801799e-01f, -1.950903220e-01f, -1.467304745e-01f, -9.801714033e-02f, -4.906767433e-02f };
__device__ __forceinline__ void p0_prologue(Frame& F) {
    LAS float* sc = (LAS float*)(F.lds);
    LAS float* red = (LAS float*)(F.lds + 36864);
    for (int idx = F.tid; idx < 9 * 1024; idx += NWAVES * 64) { const int r = idx >> 10, k = idx & 1023; const float v = (r < 8) ? F.c[r * 1024 + k] : F.c_ctx[k]; sc[idx] = v * sigm(v); }
    __syncthreads();
    for (int item = F.vcu; item < NMOD / 32; item += F.G) {
        const int n0 = item * 32, kh = F.lane >> 5, nl = F.lane & 31;
        float acc[9];
#pragma unroll
        for (int r = 0; r < 9; ++r) acc[r] = 0.f;
#pragma unroll 1
        for (int i0 = 0; i0 < 64; i0 += 32) { float wv[32];
#pragma unroll
            for (int i = 0; i < 32; ++i) wv[i] = F.w_mod[(size_t)(F.wave * 128 + 2 * (i0 + i) + kh) * NMOD + n0 + nl];
#pragma unroll
            for (int i = 0; i < 32; ++i) { const int k = F.wave * 128 + 2 * (i0 + i) + kh;
#pragma unroll
                for (int r = 0; r < 9; ++r) acc[r] += sc[r * 1024 + k] * wv[i]; } }
#pragma unroll
        for (int r = 0; r < 9; ++r) acc[r] += __shfl_xor(acc[r], 32);
        if (F.lane < 32) {
#pragma unroll
            for (int r = 0; r < 9; ++r) red[(F.wave * 9 + r) * 32 + nl] = acc[r]; }
        __syncthreads();
        if (F.tid < 288) { const int r = F.tid >> 5, n = F.tid & 31; float s = F.b_mod[n0 + n];
#pragma unroll
            for (int w = 0; w < 8; ++w) s += red[(w * 9 + r) * 32 + n];
            F.MODF[r * NMOD + n0 + n] = s; }
        __syncthreads();
    }
    LAS float* scr = (LAS float*)(F.lds + 53248 + F.wave * 8704);
    const int gw = F.vcu * NWAVES + F.wave, NGW = F.G * NWAVES;
    constexpr int I_INX = 16 * 32, I_POS = 96;
    for (int it = gw; it < I_INX + I_POS; it += NGW) {
        int r = it;
        if (r < I_INX) { p0_transpose_item(F.w_in, 1024, 4608, 0, 32, F.WIN, 0, scr, r, F.lane); continue; } r -= I_INX;
        {
            const float p = (float)(r < 32 ? r : r - 32);
#pragma unroll
            for (int j = 0; j < 8; ++j) { const int ch = j * 64 + F.lane, i = ch & 255;
                const float freq = expf(-9.210340371976184f * (float)i / 256.0f); const float ang = p * freq;
                float s, c; sincospif(ang * 0.3183098861837907f, &s, &c);
                F.POS[r * 512 + ch] = (ch < 256) ? s : c; }
        }
    }
}
__device__ __forceinline__ void p1_weight_items(Frame& F, int gw, int ngw) {
    LAS float* scr = (LAS float*)(F.lds + F.wave * 8704);
    constexpr int I_INY = 16 * 32, I_IN2 = 16 * 64, I_W1 = 16 * 128, I_W2 = 64 * 32, I_WO = 16 * 32, I_WLR = 16 * 32, I_WF = 8 * 32, I_G = 16 * 8, I_PQ = 4 * 2 * 32 * 16;
    constexpr int NITEMS = I_INY + I_IN2 + I_W1 + I_W2 + I_WO + I_WLR + I_WF + 2 * I_G + I_PQ;
    for (int it = gw; it < NITEMS; it += ngw) {
        int r = it;
        if (r < I_INY) { p0_transpose_item(F.w_in, 1024, 4608, 1024, 32, F.WIN, 1024, scr, r, F.lane); continue; } r -= I_INY;
        if (r < I_IN2) { p0_transpose_item(F.w_in, 1024, 4608, 2560, 64, F.WIN, 2048, scr, r, F.lane); continue; } r -= I_IN2;
        if (r < I_W1) { p0_transpose_item(F.w1, 1024, 4096, 0, 128, F.W1T, 0, scr, r, F.lane); continue; } r -= I_W1;
        if (r < I_W2) { p0_transpose_item(F.w2, 4096, 1024, 0, 32, F.W2T, 0, scr, r, F.lane); continue; } r -= I_W2;
        if (r < I_WO) { p0_transpose_item(F.w_out, 1024, 1024, 0, 32, F.WOUT, 0, scr, r, F.lane); continue; } r -= I_WO;
        if (r < I_WLR) { p0_transpose_item(F.w_lru_out, 1024, 1024, 0, 32, F.WL, 0, scr, r, F.lane); continue; } r -= I_WLR;
        if (r < I_WF) { p0_transpose_item(F.w_f_out, 512, 1024, 0, 32, F.WF, 0, scr, r, F.lane); continue; } r -= I_WF;
        if (r < I_G) { const int mat = r >> 3;
            p0_transpose_item(F.w_a + (size_t)mat * 16384, 128, 128, 0, 4, F.WG, mat * 256, scr, r & 7, F.lane); continue; } r -= I_G;
        if (r < I_G) { const int mat = r >> 3;
            p0_transpose_item(F.w_x + (size_t)mat * 16384, 128, 128, 0, 4, F.WG, mat * 256 + 128, scr, r & 7, F.lane); continue; } r -= I_G;
        {
            const int kc = r & 15, mc = (r >> 4) & 31, pq = (r >> 9) & 1, g = r >> 10;
            const int k = kc * 64 + F.lane, m0 = mc * 4;
            const float* wrow = F.w_in + (size_t)k * 4608 + 2048 + g * 128;
            const float* tg = c_trig128 + pq * 128;
            float acc[4] = {0.f, 0.f, 0.f, 0.f};
#pragma unroll 4
            for (int c4 = 0; c4 < 32; ++c4) { const f32x4 w4 = *(const f32x4*)(wrow + 4 * c4);
#pragma unroll
                for (int cc = 0; cc < 4; ++cc) { const int c = 4 * c4 + cc;
#pragma unroll
                    for (int mm = 0; mm < 4; ++mm) acc[mm] += tg[((m0 + mm) * c) & 127] * w4[cc]; } }
#pragma unroll
            for (int mm = 0; mm < 4; ++mm) F.WIN[(size_t)(4096 + pq * 512 + g * 128 + m0 + mm) * 1024 + k] = (bf16)f2bf(acc[mm] * (1.0f / 512.0f));
        }
    }
}

template <int MODE> __device__ __forceinline__ void norm_rows(Frame& F, const int gw  , const int nrows  , const int NGW  ) {
    const float* gvec = (MODE == 0 || MODE == 3) ? F.g_mix : (MODE == 1 ? F.g_mlp : F.g_final);
    f32x4 g[4];
#pragma unroll
    for (int j = 0; j < 4; ++j) g[j] = *(const f32x4*)(gvec + 256 * j + 4 * F.lane);
    f32x4 vn[4];
    {   const int row = gw < nrows ? gw : 0; const bool lat = row < M;
        const float* src = (MODE == 3) ? F.ctx + (size_t)row * D : (MODE == 0) ? (lat ? F.x + (size_t)row * D : F.ctx + (size_t)(row - M) * D) : F.out + (size_t)row * D;
#pragma unroll
        for (int j = 0; j < 4; ++j) vn[j] = *(const f32x4*)(src + 256 * j + 4 * F.lane); }
    for (int row = gw; row < nrows; row += NGW) {
        const bool lat = row < M;
        f32x4 v[4]; float ss = 0.f;
#pragma unroll
        for (int j = 0; j < 4; ++j) v[j] = vn[j];
        {   const int rn = (row + NGW < nrows) ? row + NGW : row; const bool latn = rn < M;
            const float* srcn = (MODE == 3) ? F.ctx + (size_t)rn * D : (MODE == 0) ? (latn ? F.x + (size_t)rn * D : F.ctx + (size_t)(rn - M) * D) : F.out + (size_t)rn * D;
#pragma unroll
            for (int j = 0; j < 4; ++j) vn[j] = *(const f32x4*)(srcn + 256 * j + 4 * F.lane); }
        if (MODE == 0 && lat) { const int t = row & (T - 1);
#pragma unroll
            for (int j = 0; j < 4; ++j) { const int c = 256 * j + 4 * F.lane;
                const f32x4 pv = (j < 2) ? *(const f32x4*)(F.POS + (t >> 6) * 512 + c) : *(const f32x4*)(F.POS + 32 * 512 + (t & 63) * 512 + (c - 512));
                v[j] = v[j] + pv; } }
#pragma unroll
        for (int j = 0; j < 4; ++j) ss += (v[j].x * v[j].x + v[j].y * v[j].y) + (v[j].z * v[j].z + v[j].w * v[j].w);
        const float rstd = 1.0f / sqrtf(wave_sum(ss) * (1.0f / D) + EPS);
        if (MODE == 2) {
#pragma unroll
            for (int j = 0; j < 4; ++j) *(f32x4*)(F.out + (size_t)row * D + 256 * j + 4 * F.lane) = v[j] * rstd * g[j];
        } else if (MODE == 3) {
#pragma unroll
            for (int j = 0; j < 4; ++j) { const f32x4 hh = v[j] * rstd * g[j]; v2u o; o.x = pk2(hh.x, hh.y); o.y = pk2(hh.z, hh.w); *(v2u*)(F.XNC + (size_t)row * D + 256 * j + 4 * F.lane) = o; }
        } else {
            const int mrow = lat ? (row >> 11) : 8;
            const float* mod = F.MODF + (size_t)mrow * NMOD + (MODE == 0 ? 0 : 3072);
            bf16* dst = (MODE == 0) ? (lat ? F.HLAT + (size_t)row * D : F.HCTX + (size_t)(row - M) * D) : F.UY + (size_t)row * D;
#pragma unroll
            for (int j = 0; j < 4; ++j) { const int c = 256 * j + 4 * F.lane;
                const f32x4 sh = *(const f32x4*)(mod + c), scl = *(const f32x4*)(mod + 1024 + c);
                const f32x4 h = v[j] * rstd * g[j] * (scl + 1.0f) + sh;
                v2u o; o.x = pk2(h.x, h.y); o.y = pk2(h.z, h.w);
                *(v2u*)(dst + c) = o; }
        }
    }
}

__device__ __forceinline__ void conv_phase(Frame& F) {
    const int gw = F.vcu * NWAVES + F.wave, NGW = F.G * NWAVES, lane = F.lane;
#ifndef REPC
#define REPC 1
#endif
    for (int it_ = gw; it_ < 4608 * REPC; it_ += NGW) { const int it = it_ % 4608;
        const bool lat = it < 4096; const int r = lat ? it : it - 4096;
        const int half = r & 1, row0 = (r >> 1) * 8;
        const int Tseg = lat ? T : CT; const int t0 = row0 & (Tseg - 1);
        const int c0 = half * 512 + lane * 8;
        const bf16* src = (lat ? F.UX : F.UXC) + (size_t)(row0 - t0) * D + c0;
        bf16* dst = (lat ? F.XC : F.XCC) + (size_t)(row0 - t0) * D + c0;
        v4u v[11];
#pragma unroll
        for (int i = 0; i < 11; ++i) { const int tt = t0 - 2 + i; v[i] = (tt >= 0 && tt < Tseg) ? *(const v4u*)(src + (size_t)tt * D) : (v4u){0u, 0u, 0u, 0u}; }
        f32x4 cw[4][2], cb[2];
#pragma unroll
        for (int k = 0; k < 4; ++k) { cw[k][0] = *(const f32x4*)(F.conv_w + k * 1024 + c0); cw[k][1] = *(const f32x4*)(F.conv_w + k * 1024 + c0 + 4); }
        cb[0] = *(const f32x4*)(F.conv_b + c0); cb[1] = *(const f32x4*)(F.conv_b + c0 + 4);
#pragma unroll
        for (int o = 0; o < 8; ++o) { f32x4 x0 = cb[0], x1 = cb[1];
#pragma unroll
            for (int k = 0; k < 4; ++k) { const v4u u = v[o + k];
                x0[0] += cw[k][0][0] * bflo(u.x); x0[1] += cw[k][0][1] * bfhi(u.x); x0[2] += cw[k][0][2] * bflo(u.y); x0[3] += cw[k][0][3] * bfhi(u.y);
                x1[0] += cw[k][1][0] * bflo(u.z); x1[1] += cw[k][1][1] * bfhi(u.z); x1[2] += cw[k][1][2] * bflo(u.w); x1[3] += cw[k][1][3] * bfhi(u.w); }
            *(v4u*)(dst + (size_t)(t0 + o) * D) = pg8::pack8(x0, x1); }
    }
}


constexpr int FT_ZROW = 144, FT_GROW = 80, FT_A1 = 81920, FT_A2 = FT_A1 + 32768;
__device__ __forceinline__ void fft_phase(Frame& F) {
    const int w = F.wave;
    LAS unsigned char* zs = F.lds;
    const int mtile = w & 3, nhalf = w >> 2;
    {   const int lane = F.lane, h = lane >> 5, cl = lane & 31; const int ri = cl >> 4, k1 = 16 * mtile + (cl & 15);
        if (w < 4) {
#pragma unroll
            for (int ks = 0; ks < 8; ++ks) { const int pq = ks >> 2; bf16x8 fr;
#pragma unroll
                for (int j = 0; j < 8; ++j) { const int t1 = 16 * (ks & 3) + 8 * h + j; const int ix = 2 * ((k1 * t1) & 63); const float c = c_trig128[ix], s = c_trig128[128 + ix];
                    const float v = (ri == 0) ? (pq == 0 ? c : -s) : (pq == 0 ? s : c);
                    fr[j] = (short)f2bf(v); }
                *(LAS bf16x8*)(F.lds + FT_A1 + ((mtile * 8 + ks) * 64 + lane) * 16) = fr; }
        } else if (w == 4) {
#pragma unroll
            for (int ks = 0; ks < 4; ++ks) { const int ri2 = ks >> 1; bf16x8 fr;
#pragma unroll
                for (int j = 0; j < 8; ++j) { const int t2 = 16 * (ks & 1) + 8 * h + j; const int ix = 4 * ((cl * t2) & 31); const float c = c_trig128[ix], s = c_trig128[128 + ix];
                    fr[j] = (short)f2bf(ri2 == 0 ? c : -s); }
                *(LAS bf16x8*)(F.lds + FT_A2 + (ks * 64 + lane) * 16) = fr; }
        }
    }
    __syncthreads();
#ifndef REPF
#define REPF 1
#endif
    for (int item_ = F.vcu; item_ < NB * 64 * REPF; item_ += F.G) { const int item = item_ & (NB * 64 - 1);
        const int b = item >> 6, c0 = (item & 63) * 8;
        int lv = F.lane; asm volatile("" : "+v"(lv));
        const int lane = lv, h = lane >> 5, cl = lane & 31;
        {   v4u zv[8];
#pragma unroll
            for (int j = 0; j < 8; ++j) { const int u = w * 8 + j, pq = u >> 5, t2 = u & 31;
                zv[j] = *(const v4u*)(F.PQ + ((size_t)b * T + 32 * lane + t2) * D + pq * 512 + c0); }
#pragma unroll
            for (int j = 0; j < 8; ++j) { const int u = w * 8 + j;
                LAS unsigned char* zp = zs + (u * 8) * FT_ZROW + lane * 2;
                *(LAS unsigned short*)(zp + 0 * FT_ZROW) = (unsigned short)(zv[j].x & 0xffffu); *(LAS unsigned short*)(zp + 1 * FT_ZROW) = (unsigned short)(zv[j].x >> 16);
                *(LAS unsigned short*)(zp + 2 * FT_ZROW) = (unsigned short)(zv[j].y & 0xffffu); *(LAS unsigned short*)(zp + 3 * FT_ZROW) = (unsigned short)(zv[j].y >> 16);
                *(LAS unsigned short*)(zp + 4 * FT_ZROW) = (unsigned short)(zv[j].z & 0xffffu); *(LAS unsigned short*)(zp + 5 * FT_ZROW) = (unsigned short)(zv[j].z >> 16);
                *(LAS unsigned short*)(zp + 6 * FT_ZROW) = (unsigned short)(zv[j].w & 0xffffu); *(LAS unsigned short*)(zp + 7 * FT_ZROW) = (unsigned short)(zv[j].w >> 16); }
        }
        __syncthreads();
        f32x16 acc[4];
#pragma unroll
        for (int nt = 0; nt < 4; ++nt)
#pragma unroll
            for (int i = 0; i < 16; ++i) acc[nt][i] = 0.f;
#pragma unroll
        for (int ks = 0; ks < 8; ++ks) { const int pq = ks >> 2; const bf16x8 a1 = *(const LAS bf16x8*)(F.lds + FT_A1 + ((mtile * 8 + ks) * 64 + lane) * 16);
#pragma unroll
            for (int nt = 0; nt < 4; ++nt) { const int ng = (nhalf * 4 + nt) * 32 + cl;
                const bf16x8 bf = *(const LAS bf16x8*)(zs + (pq * 256 + ng) * FT_ZROW + (16 * (ks & 3) + 8 * h) * 2);
                acc[nt] = __builtin_amdgcn_mfma_f32_32x32x16_bf16(a1, bf, acc[nt], 0, 0, 0); } }
        __syncthreads();
#pragma unroll
        for (int nt = 0; nt < 4; ++nt) { const int ng = (nhalf * 4 + nt) * 32 + cl, t2 = ng >> 3, c = ng & 7;
            float sb, cb, s1, c1, s8, c8;
            sincospif((float)((16 * mtile + 4 * h) * t2) * (1.0f / 1024.0f), &sb, &cb);
            sincospif((float)t2 * (1.0f / 1024.0f), &s1, &c1);
            sincospif((float)(8 * t2) * (1.0f / 1024.0f), &s8, &c8);
#pragma unroll
            for (int r = 0; r < 8; ++r) { const int k1 = 16 * mtile + (r & 3) + 8 * (r >> 2) + 4 * h;
                if (r == 4) { const float cn = cb * c8 - sb * s8, sn = sb * c8 + cb * s8; cb = cn; sb = sn; }
                float cp = cb, sp = sb;
                if ((r & 3) >= 1) { const float cn = cp * c1 - sp * s1, sn = sp * c1 + cp * s1; cp = cn; sp = sn; }
                if ((r & 3) >= 2) { const float cn = cp * c1 - sp * s1, sn = sp * c1 + cp * s1; cp = cn; sp = sn; }
                if ((r & 3) >= 3) { const float cn = cp * c1 - sp * s1, sn = sp * c1 + cp * s1; cp = cn; sp = sn; }
                const float re = acc[nt][r], im = acc[nt][r + 8];
                const float re2 = re * cp - im * sp, im2 = re * sp + im * cp;
                *(LAS unsigned short*)(zs + ((k1) * 8 + c) * FT_GROW + t2 * 2) = (unsigned short)f2bf(re2);
                *(LAS unsigned short*)(zs + ((64 + k1) * 8 + c) * FT_GROW + t2 * 2) = (unsigned short)f2bf(im2); } }
        __syncthreads();
        f32x16 acc2[2];
#pragma unroll
        for (int nt = 0; nt < 2; ++nt)
#pragma unroll
            for (int i = 0; i < 16; ++i) acc2[nt][i] = 0.f;
#pragma unroll
        for (int ks = 0; ks < 4; ++ks) { const int ri2 = ks >> 1; const bf16x8 a2 = *(const LAS bf16x8*)(F.lds + FT_A2 + (ks * 64 + lane) * 16);
#pragma unroll
            for (int nt = 0; nt < 2; ++nt) { const int ng = (2 * w + nt) * 32 + cl;
                const bf16x8 bf = *(const LAS bf16x8*)(zs + (ri2 * 512 + ng) * FT_GROW + (16 * (ks & 1) + 8 * h) * 2);
                acc2[nt] = __builtin_amdgcn_mfma_f32_32x32x16_bf16(a2, bf, acc2[nt], 0, 0, 0); } }
#pragma unroll
        for (int nt = 0; nt < 2; ++nt) { const int ng = (2 * w + nt) * 32 + cl, k1 = ng >> 3, c = ng & 7;
#pragma unroll
            for (int reg = 0; reg < 16; ++reg) { const int k2 = (reg & 3) + 8 * (reg >> 2) + 4 * h;
                F.YF[((size_t)b * T + k1 + 64 * k2) * FW + c0 + c] = (bf16)f2bf(acc2[nt][reg]); } }
        __syncthreads();
    }
}

constexpr int SC_W = 0;
constexpr int SC_TAB = 2 * 64 * 272;
template <int DIR>
__device__ __forceinline__ void scan_pass(Frame& F, int b, int hd, int q, float& carry, int& round, bf16* ya_dst) {
    const int lane0 = F.lane, w = F.wave, h0 = lane0 >> 5, cl0 = lane0 & 31;
    const LAS unsigned char* wl = F.lds + SC_W + DIR * (64 * 272);
    LAS float* tab = (LAS float*)(F.lds + SC_TAB);
    const int ch0 = hd * 128 + q * 32 + cl0;
    constexpr float L2E = 1.4426950408889634f;
    const float cr = -F.b_a[DIR * 1024 + ch0] * L2E, ci = -F.b_x[DIR * 1024 + ch0] * L2E;
    const float nsp8 = -8.0f * log1pf(expf(-F.lam[DIR * 1024 + ch0]));
    const float nsp8l = nsp8 * L2E;
    bf16x8 I0, I1;
#pragma unroll
    for (int j = 0; j < 8; ++j) { I0[j] = (8 * h0 + j == cl0) ? (short)0x3F80 : (short)0; I1[j] = (16 + 8 * h0 + j == cl0) ? (short)0x3F80 : (short)0; }
    const bf16* xlat = F.XC + (size_t)b * T * D + hd * 128 + 8 * h0 + (size_t)cl0 * D;
    const bf16* xctx = F.XCC + (size_t)b * CT * D + hd * 128 + 8 * h0 + (size_t)cl0 * D;
#define SC_R0(R_) ((R_) == 0 ? 0 : ((DIR == 0) ? ((R_) - 1) : (4 - (R_))) * 512)
#define SC_PTR(R_, mt_) (((R_) == 0 ? xctx : xlat) + (size_t)(SC_R0(R_) + 64 * w + 32 * (mt_)) * D)
#define SC_LOADX(X_, R_, mt_) do { const bf16* p_ = SC_PTR(R_, mt_); _Pragma("unroll") for (int ks_ = 0; ks_ < 8; ++ks_) X_[ks_] = *(const bf16x8*)(p_ + ks_ * 16); } while (0)
    bf16x8 X0[8], X1[8];
    const int firstR = (w < 4) ? 0 : 1;
    SC_LOADX(X0, firstR, 0);
#pragma unroll 1
    for (int R = 0; R < 5; ++R) {
        int lv = F.lane; asm volatile("" : "+v"(lv));
        const int lane = lv, h = lane >> 5, cl = lane & 31; const int ch = hd * 128 + q * 32 + cl;
        const int r0 = SC_R0(R);
        const int nact = (R == 0) ? 4 : 8;
        const bool active = w < nact;
        const int t0 = r0 + 64 * w;
        float av[2][16], bv[2][16];
        float preA[8], preH[8];
        bf16x8 Yh[2][2], Yu[2][2];
#define SC_LOADY(mt_) do { _Pragma("unroll") for (int s_ = 0; s_ < 2; ++s_) { const size_t o_ = ((size_t)b * T + t0 + 32 * (mt_) + cl) * D + hd * 128 + q * 32 + 16 * s_ + 8 * h; \
            Yh[mt_][s_] = *(const bf16x8*)(F.HLAT + o_); Yu[mt_][s_] = *(const bf16x8*)(F.UY + o_); } } while (0)
        if (active) {
#pragma unroll
            for (int mt = 0; mt < 2; ++mt) {
                if (mt == 0) SC_LOADX(X1, R, 1); else { const int Rn = (R < 4) ? R + 1 : R; SC_LOADX(X0, Rn, 0); }
                f32x16 accr, acci, accx;
#pragma unroll
                for (int i = 0; i < 16; ++i) { accr[i] = 0.f; acci[i] = 0.f; accx[i] = 0.f; }
#pragma unroll
                for (int ks = 0; ks < 8; ++ks) { const bf16x8 af = (mt == 0) ? X0[ks] : X1[ks];
                    const bf16x8 br = *(const LAS bf16x8*)(wl + cl * 272 + (ks * 16 + 8 * h) * 2);
                    const bf16x8 bi = *(const LAS bf16x8*)(wl + (32 + cl) * 272 + (ks * 16 + 8 * h) * 2);
                    accr = __builtin_amdgcn_mfma_f32_32x32x16_bf16(af, br, accr, 0, 0, 0);
                    acci = __builtin_amdgcn_mfma_f32_32x32x16_bf16(af, bi, acci, 0, 0, 0); }
                __builtin_amdgcn_sched_barrier(0);
                {
                    bf16x8 fa, fb;
                    if (mt == 0) { fa = (q == 0) ? X0[0] : (q == 1) ? X0[2] : (q == 2) ? X0[4] : X0[6]; fb = (q == 0) ? X0[1] : (q == 1) ? X0[3] : (q == 2) ? X0[5] : X0[7]; }
                    else         { fa = (q == 0) ? X1[0] : (q == 1) ? X1[2] : (q == 2) ? X1[4] : X1[6]; fb = (q == 0) ? X1[1] : (q == 1) ? X1[3] : (q == 2) ? X1[5] : X1[7]; }
                    accx = __builtin_amdgcn_mfma_f32_32x32x16_bf16(fa, I0, accx, 0, 0, 0);
                    accx = __builtin_amdgcn_mfma_f32_32x32x16_bf16(fb, I1, accx, 0, 0, 0); }
                __builtin_amdgcn_sched_barrier(0);
#pragma unroll
                for (int reg = 0; reg < 16; ++reg) {
                    const float e1 = __builtin_amdgcn_exp2f(accr[reg] * (-L2E) + cr), e2 = __builtin_amdgcn_exp2f(acci[reg] * (-L2E) + ci);
                    const float rg = __builtin_amdgcn_rcpf(1.0f + e1), ig = __builtin_amdgcn_rcpf(1.0f + e2);
                    const float a = __builtin_amdgcn_exp2f(nsp8l * rg);
                    const float x2 = 2.0f * nsp8 * rg;
                    float pz = x2 * (1.0f / 24.0f) + (1.0f / 6.0f); pz = pz * x2 + 0.5f; pz = pz * x2 + 1.0f;
                    const float m2 = (x2 > -0.3f) ? (-x2 * pz) : (1.0f - a * a);
                    av[mt][reg] = a; bv[mt][reg] = __builtin_amdgcn_sqrtf(m2) * ig * accx[reg]; }
                __builtin_amdgcn_sched_barrier(0);
            }
            __builtin_amdgcn_sched_barrier(0);
            float gA[8], gH[8];
#pragma unroll
            for (int mt = 0; mt < 2; ++mt)
#pragma unroll
                for (int g4 = 0; g4 < 4; ++g4) { float ar = 1.f, hr = 0.f;
#pragma unroll
                    for (int ii = 0; ii < 4; ++ii) { const int i = g4 * 4 + (DIR == 0 ? ii : 3 - ii);
                        hr = av[mt][i] * hr + bv[mt][i]; ar = ar * av[mt][i]; av[mt][i] = ar; bv[mt][i] = hr; }
                    gA[mt * 4 + g4] = ar; gH[mt * 4 + g4] = hr; }
            float pA[8], pH[8];
#pragma unroll
            for (int gi = 0; gi < 8; ++gi) { pA[gi] = __shfl_xor(gA[gi], 32); pH[gi] = __shfl_xor(gH[gi], 32); }
            float Ar = 1.f, Hr = 0.f;
#pragma unroll
            for (int gg = 0; gg < 8; ++gg) { const int gi = (DIR == 0) ? gg : 7 - gg;
                const bool own_first = (DIR == 0) ? (h == 0) : (h == 1);
                const float fA = own_first ? gA[gi] : pA[gi], fH = own_first ? gH[gi] : pH[gi];
                const float sA = own_first ? pA[gi] : gA[gi], sH = own_first ? pH[gi] : gH[gi];
                const float Ar1 = fA * Ar, Hr1 = fA * Hr + fH;
                preA[gi] = own_first ? Ar : Ar1; preH[gi] = own_first ? Hr : Hr1;
                Ar = sA * Ar1; Hr = sA * Hr1 + sH; }
            __builtin_amdgcn_sched_barrier(0);
            if (DIR == 1 && R > 0) SC_LOADY(0);
            if (lane < 32) { tab[((round & 1) * 8 + w) * 64 + cl] = Ar; tab[((round & 1) * 8 + w) * 64 + 32 + cl] = Hr; }
        }
        __syncthreads();
        float my = carry; { float c = carry;
#pragma unroll
            for (int ww = 0; ww < 8; ++ww) { const int w2 = (DIR == 0) ? ww : 7 - ww;
                if (w2 < nact) { if (w2 == w) my = c; c = tab[((round & 1) * 8 + w2) * 64 + cl] * c + tab[((round & 1) * 8 + w2) * 64 + 32 + cl]; } }
            carry = c; }
        ++round;
        if (active && R > 0) {
            if (DIR == 1) SC_LOADY(1);
#pragma unroll
            for (int mt = 0; mt < 2; ++mt) {
                f32x16 hfC, gyC;
                if (DIR == 1) {
#pragma unroll
                    for (int i = 0; i < 16; ++i) { hfC[i] = 0.f; gyC[i] = 0.f; }
                    hfC = __builtin_amdgcn_mfma_f32_32x32x16_bf16(Yh[mt][0], I0, hfC, 0, 0, 0); hfC = __builtin_amdgcn_mfma_f32_32x32x16_bf16(Yh[mt][1], I1, hfC, 0, 0, 0);
                    gyC = __builtin_amdgcn_mfma_f32_32x32x16_bf16(Yu[mt][0], I0, gyC, 0, 0, 0); gyC = __builtin_amdgcn_mfma_f32_32x32x16_bf16(Yu[mt][1], I1, gyC, 0, 0, 0); }
#pragma unroll
                for (int reg = 0; reg < 16; ++reg) { const int gi = mt * 4 + (reg >> 2);
                    const float gc = preH[gi] + preA[gi] * my;
                    const float hv = bv[mt][reg] + av[mt][reg] * gc;
                    const int tok = t0 + 32 * mt + 8 * (reg >> 2) + 4 * h + (reg & 3);
                    const size_t idx = ((size_t)b * T + tok) * D + ch;
                    if (DIR == 0) F.HLAT[idx] = (bf16)(pg8::cvt_pk_bf16(hv, hv) & 0xffffu);
                    else { const float y = (hfC[reg] + hv) * gyC[reg]; ya_dst[idx] = (bf16)(pg8::cvt_pk_bf16(y, y) & 0xffffu); } }
            }
        }
    }
#undef SC_R0
#undef SC_PTR
#undef SC_LOADX
#undef SC_LOADY
}
__device__ __forceinline__ void scan_phase(Frame& F, bf16* ya_dst) {
    int round = 0;
    for (int item = F.vcu; item < NB * 8 * 4; item += F.G) {
        const int q = item & 3, hd = (item >> 2) & 7, b = item >> 5;
        for (int i = F.tid; i < 2048; i += NWAVES * 64) { const int ck = i & 15, row = (i >> 4) & 63, dir = i >> 10; const int g = row >> 5, e = row & 31;
            const v4u v = *(const v4u*)(F.WG + ((size_t)((dir * 8 + hd) * 256 + g * 128 + q * 32 + e)) * 128 + ck * 8);
            *(LAS v4u*)(F.lds + SC_W + dir * (64 * 272) + row * 272 + ck * 16) = v; }
        __syncthreads();
        float carry = 0.f;
        scan_pass<0>(F, b, hd, q, carry, round, ya_dst);
        VM_WAIT(); __syncthreads();
        carry = 0.f;
        scan_pass<1>(F, b, hd, q, carry, round, ya_dst);
        __syncthreads();
    }
}

struct Args { const float* in[22]; float* out; unsigned char* ws; int ph_lo, ph_hi; };
__global__ void __launch_bounds__(NWAVES * 64, 2) mk_fwd(Args args) {
    extern __shared__ __attribute__((aligned(16))) unsigned char lds[];
    Frame F;
    F.lds = (LAS unsigned char*)lds;
    F.MISC = (volatile LAS unsigned*)(F.lds + MISC_OFF);
    F.tid = threadIdx.x; F.lane = F.tid & 63; F.wave = __builtin_amdgcn_readfirstlane(F.tid >> 6);
    F.G = gridDim.x; { const int bx = blockIdx.x; F.vcu = (F.G % 8 == 0) ? (bx % 8) * (F.G / 8) + bx / 8 : bx; }
    unsigned char* ws = args.ws;
    F.ctl = (gu32*)(ws + WS_CTL);
    F.x = args.in[0]; F.c = args.in[1]; F.ctx = args.in[2]; F.c_ctx = args.in[3]; F.w_mod = args.in[4]; F.b_mod = args.in[5]; F.g_mix = args.in[6]; F.w_in = args.in[7];
    F.conv_w = args.in[8]; F.conv_b = args.in[9]; F.w_a = args.in[10]; F.b_a = args.in[11]; F.w_x = args.in[12]; F.b_x = args.in[13]; F.lam = args.in[14];
    F.w_lru_out = args.in[15]; F.w_f_out = args.in[16]; F.w_out = args.in[17]; F.g_mlp = args.in[18]; F.w1 = args.in[19]; F.w2 = args.in[20]; F.g_final = args.in[21];
    F.out = args.out;
    F.MODF = (float*)(ws + WS_MODF); F.POS = (float*)(ws + WS_POS);
    F.WIN = (bf16*)(ws + WS_WIN); F.W1T = (bf16*)(ws + WS_W1); F.W2T = (bf16*)(ws + WS_W2); F.WOUT = (bf16*)(ws + WS_WOUT); F.WL = (bf16*)(ws + WS_WL); F.WF = (bf16*)(ws + WS_WF); F.WG = (bf16*)(ws + WS_WG);
    F.HCTX = (bf16*)(ws + WS_HCTX); F.UXC = (bf16*)(ws + WS_UXC); F.HLAT = (bf16*)(ws + WS_HLAT); F.UX = (bf16*)(ws + WS_UX); F.PQ = (bf16*)(ws + WS_PQT); F.YF = (bf16*)(ws + WS_YF);
    F.HID = (bf16*)(ws + WS_HID); F.UY = (bf16*)(ws + WS_UY); F.YB = (bf16*)(ws + WS_YB); F.UG = (bf16*)args.out; F.XC = F.YB; F.XCC = F.HCTX; F.XNC = (bf16*)(ws + 42 * MiB);
    for (int u = F.tid; u < (LDS_BYTES - LDSCTL_OFF) / 4; u += NWAVES * 64) ((LAS unsigned*)(F.lds + LDSCTL_OFF))[u] = 0u;
    __syncthreads();
    const bool one_launch = (args.ph_hi - args.ph_lo) > 1;
    XcdBarrier bar; bar.bar = (unsigned*)(F.ctl + CW_BAR); bar.x = 0; bar.st = nullptr;
    if (one_launch) bar = xcd_barrier_post((unsigned*)(F.ctl + CW_BAR), F.MISC + 8);
    const int lo = args.ph_lo, hi = args.ph_hi;
#ifdef ONLY_PH
#define IN(k) ((k) == ONLY_PH)
#else
#define IN(k) (lo <= (k) && (k) < hi)
#endif
#define SEAM(k) do { if (IN(k) && IN((k) + 1)) xcd_barrier(bar); } while (0)
    using pg8::Gemm; using pg8::StaticOrder;
    const int cid = (int)blockIdx.x;

#ifndef REP_PH
#define REP_PH -1
#define REP_N 1
#endif
#define REPS(k) ((k) == REP_PH ? (REP_N + lo) : 1)
#define REPBAR(k) do { if (rep + 1 < REPS(k)) xcd_barrier(bar); } while (0)
    int ph = 0;
#define PHASE_BEGIN if (IN(ph)) { _Pragma("unroll 1") for (int rep = 0; rep < REPS(ph); ++rep) {
#define PHASE_END   REPBAR(ph); } SEAM(ph); } ++ph;
    PHASE_BEGIN p0_prologue(F); norm_rows<3>(F, F.vcu * NWAVES + F.wave, MC, F.G * NWAVES); PHASE_END
    PHASE_BEGIN
        if ((F.vcu & 7) == 0) {
            const int j = F.vcu >> 3;
            {
                const int c8 = (F.tid & 127) * 8; const float* mod = F.MODF + (size_t)8 * NMOD;
                const f32x4 sh0 = *(const f32x4*)(mod + c8), sh1 = *(const f32x4*)(mod + c8 + 4), sc0 = *(const f32x4*)(mod + 1024 + c8) + 1.0f, sc1 = *(const f32x4*)(mod + 1024 + c8 + 4) + 1.0f;
#pragma unroll 8
                for (int i = 0; i < 64; ++i) { const size_t o = (size_t)((j >> 2) * 256 + (F.tid >> 7) + 4 * i) * D + c8;
                    const v4u u = *(const v4u*)(F.XNC + o);
                    f32x4 a = (f32x4){bflo(u.x), bfhi(u.x), bflo(u.y), bfhi(u.y)} * sc0 + sh0, b2 = (f32x4){bflo(u.z), bfhi(u.z), bflo(u.w), bfhi(u.w)} * sc1 + sh1;
                    *(v4u*)(F.HCTX + o) = pg8::pack8(a, b2); }
            }
            VM_WAIT(); __syncthreads();
            Gemm g{F.HCTX, F.WIN, MC, 1024, D}; pg8::OneUnit S{j >> 2, j & 3}; pg8::EpiBf16<0> E{F.UXC, D};
            pg8::gemm_phase<pg8::EpiBf16<0>, pg8::OneUnit, true, true>(F.lds + RING_OFF, g, S, E);
        } else {
            const int rank = F.vcu - (F.vcu >> 3) - 1, nrank = F.G - F.G / 8;
            norm_rows<0>(F, rank * NWAVES + F.wave, M, nrank * NWAVES);
            p1_weight_items(F, rank * NWAVES + F.wave, nrank * NWAVES);
        }
    PHASE_END
    PHASE_BEGIN
        { Gemm g{F.HLAT, F.WIN, M, 5120, D}; StaticOrder S; S.init(M, 5120, F.G, cid); pg8::EpiInMain E{F.UX, F.UY, F.UG, F.PQ};
          pg8::gemm_phase<pg8::EpiInMain, StaticOrder, true, true>(F.lds + RING_OFF, g, S, E); }
    PHASE_END
#ifndef NO_CONV
    PHASE_BEGIN conv_phase(F);
#else
    PHASE_BEGIN
#endif
#ifndef NO_FFT
    fft_phase(F);
#endif
#ifdef X3_FFT
    __syncthreads(); fft_phase(F); __syncthreads(); fft_phase(F);
#endif
#ifdef X3_CONV
    conv_phase(F); conv_phase(F);
#endif
    PHASE_END
    PHASE_BEGIN scan_phase(F, rep + 1 < REPS(ph) ? F.UX : F.UY); PHASE_END
    PHASE_BEGIN
        Gemm g{F.YF, F.WF, M, D, FW}; StaticOrder S; S.init(M, D, F.G, cid); pg8::EpiGate<false> E{F.YB, D, F.UG + 1024, 2048, nullptr};
        pg8::gemm_phase<pg8::EpiGate<false>, StaticOrder, true, true>(F.lds + RING_OFF, g, S, E);
    PHASE_END
    PHASE_BEGIN
        Gemm g{F.UY, F.WL, M, D, D}; StaticOrder S; S.init(M, D, F.G, cid); pg8::EpiGate<true> E{F.UX, D, F.UG, 2048, F.YB};
        pg8::gemm_phase<pg8::EpiGate<true>, StaticOrder, true, true>(F.lds + RING_OFF, g, S, E);
    PHASE_END
    PHASE_BEGIN
        Gemm g{F.UX, F.WOUT, M, D, D}; StaticOrder S; S.init(M, D, F.G, cid); pg8::EpiResid<0> E{F.x, F.out, F.MODF + 2048, F.POS};
        pg8::gemm_phase<pg8::EpiResid<0>, StaticOrder, true, true>(F.lds + RING_OFF, g, S, E);
    PHASE_END
    PHASE_BEGIN norm_rows<1>(F, F.vcu * NWAVES + F.wave, M, F.G * NWAVES); PHASE_END
    PHASE_BEGIN
        Gemm g{F.UY, F.W1T, M, FF, D}; StaticOrder S; S.init(M, FF, F.G, cid); pg8::EpiBf16<1> E{F.HID, FF};
        pg8::gemm_phase<pg8::EpiBf16<1>, StaticOrder, true, true>(F.lds + RING_OFF, g, S, E);
    PHASE_END
    PHASE_BEGIN
        Gemm g{F.HID, F.W2T, M, D, FF}; StaticOrder S; S.init(M, D, F.G, cid); pg8::EpiResid<1> E{nullptr, F.out, F.MODF + 5120, nullptr};
        pg8::gemm_phase<pg8::EpiResid<1>, StaticOrder, true, true>(F.lds + RING_OFF, g, S, E);
    PHASE_END
    PHASE_BEGIN norm_rows<2>(F, F.vcu * NWAVES + F.wave, M, F.G * NWAVES); PHASE_END
#undef IN
#undef SEAM
}

extern "C" void kernel_launch(void* const* d_in, const int* in_sizes, int n_in, void* d_out, int out_size, void* d_ws, size_t ws_size, hipStream_t stream) {
    static int grid = 0;
    if (grid == 0) {
        if (n_in != 22 || in_sizes[0] != M * D || out_size != M * D || ws_size < WS_END) { fprintf(stderr, "kernel_launch: unexpected shapes (n_in %d, in0 %d, out %d, ws %zu); nothing launched\n", n_in, n_in > 0 ? in_sizes[0] : -1, out_size, ws_size); grid = -1; return; }
        int dev = 0, cus = 0, per_cu = 0;
        if (hipGetDevice(&dev) != hipSuccess || hipDeviceGetAttribute(&cus, hipDeviceAttributeMultiprocessorCount, dev) != hipSuccess) { fprintf(stderr, "kernel_launch: device query failed\n"); grid = -1; return; }
        if (hipFuncSetAttribute((const void*)mk_fwd, hipFuncAttributeMaxDynamicSharedMemorySize, LDS_BYTES) != hipSuccess) { fprintf(stderr, "kernel_launch: hipFuncSetAttribute failed\n"); grid = -1; return; }
        if (hipOccupancyMaxActiveBlocksPerMultiprocessor(&per_cu, (const void*)mk_fwd, NWAVES * 64, LDS_BYTES) != hipSuccess || per_cu < 1) { fprintf(stderr, "kernel_launch: occupancy query reports %d workgroups per CU\n", per_cu); (void)hipGetLastError(); grid = -1; return; }
        grid = cus;
    }
    if (grid < 0) return;
    if (hipMemsetAsync((char*)d_ws + WS_CTL, 0, CTL_ZERO_BYTES, stream) != hipSuccess) { fprintf(stderr, "kernel_launch: hipMemsetAsync failed\n"); return; }
    Args a{};
    for (int i = 0; i < 22; ++i) a.in[i] = (const float*)d_in[i];
    a.out = (float*)d_out; a.ws = (unsigned char*)d_ws;
    if (N_LAUNCHES == 1) {
        a.ph_lo = 0; a.ph_hi = N_PHASES;
        void* kargs[] = {&a};
        const hipError_t le = hipLaunchCooperativeKernel((const void*)mk_fwd, dim3(grid), dim3(NWAVES * 64), kargs, LDS_BYTES, stream);
        if (le != hipSuccess) fprintf(stderr, "kernel_launch: cooperative launch failed: %s (grid %d)\n", hipGetErrorName(le), grid);
    } else {
        for (int li = 0; li < N_PHASES; ++li) {
            a.ph_lo = li; a.ph_hi = li + 1;
            hipLaunchKernelGGL(mk_fwd, dim3(grid), dim3(NWAVES * 64), LDS_BYTES, stream, a);
            const hipError_t le = hipPeekAtLastError();
            if (le != hipSuccess) { fprintf(stderr, "kernel_launch: launch %d failed: %s\n", li, hipGetErrorName(le)); break; }
        }
    }
}
```
